# Optimizing an MI355X kernel written in HIP

```python
import jax, jax.numpy as jnp
from jax import lax
import numpy as np

D_MODEL = 1024
BATCH = 4
SEQ = 8192
DEPTH = 2

N_MEM = 256
HEAD_DIM = 64
N_Q_HEADS = 8
N_KV_HEADS = 2
Q_PER_KV = N_Q_HEADS // N_KV_HEADS
ATTN_WIDTH = N_Q_HEADS * HEAD_DIM
KV_WIDTH = N_KV_HEADS * HEAD_DIM
WINDOW = 128
BLOCK = 128
ROPE_THETA = 10000.0
POOL_WINDOWS = (2, 4, 8, 16)
N_POOL_GROUPS = len(POOL_WINDOWS)
POOL_WIDTH = D_MODEL - ATTN_WIDTH
POOL_GROUP_DIM = POOL_WIDTH // N_POOL_GROUPS
MIX_WIDTH = ATTN_WIDTH + POOL_WIDTH
IN_WIDTH = ATTN_WIDTH + 2 * KV_WIDTH + POOL_WIDTH
X_HEADS = 4
X_HEAD_DIM = D_MODEL // X_HEADS
X_WIDTH = X_HEADS * X_HEAD_DIM
D_FF = 2816
FFN_RES = 0.5
EPS = 1e-6
MAX_POS_OFFSET = 1024
NEG = -1e30

kernel_name = "hymba_swa_sink_pool_macaron_xattn"


def rms_norm(x, g):
    xf = x.astype(jnp.float32)
    y = xf * lax.rsqrt(jnp.mean(xf * xf, axis=-1, keepdims=True) + EPS)
    return (y * g.astype(jnp.float32)).astype(x.dtype)


def swiglu(h, w_gate, w_up, w_down):
    return (jax.nn.silu(h @ w_gate) * (h @ w_up)) @ w_down


def rope_tables(positions):
    inv_freq = ROPE_THETA ** (-jnp.arange(0, HEAD_DIM, 2, dtype=jnp.float32) / HEAD_DIM)
    ang = positions.astype(jnp.float32)[..., None] * inv_freq
    return jnp.cos(ang)[:, :, None, :], jnp.sin(ang)[:, :, None, :]


def apply_rope(t, cos, sin):
    tf = t.astype(jnp.float32)
    t1, t2 = tf[..., : HEAD_DIM // 2], tf[..., HEAD_DIM // 2:]
    return jnp.concatenate([t1 * cos - t2 * sin, t2 * cos + t1 * sin], axis=-1).astype(t.dtype)


def sliding_window_sink_attention(q, k, v, sinks):
    B, S = q.shape[0], q.shape[1]
    nb = S // BLOCK
    qb = q.reshape(B, nb, BLOCK, N_KV_HEADS, Q_PER_KV, HEAD_DIM)

    def with_prev(t):
        tb = t.reshape(B, nb, BLOCK, N_KV_HEADS, HEAD_DIM)
        prev = jnp.pad(tb[:, :-1], ((0, 0), (1, 0), (0, 0), (0, 0), (0, 0)))
        return jnp.concatenate([prev, tb], axis=2)

    kk, vv = with_prev(k), with_prev(v)
    scale = HEAD_DIM ** -0.5
    s = jnp.einsum('bnqkgd,bnjkd->bkgnqj', qb, kk).astype(jnp.float32) * scale
    qi = jnp.arange(BLOCK)[:, None]
    kj = jnp.arange(2 * BLOCK)[None, :]
    diff = qi + BLOCK - kj
    blk = jnp.arange(nb)[:, None, None]
    key_abs = (blk - 1) * BLOCK + kj[None]
    mask = (diff >= 0)[None] & (diff < WINDOW)[None] & (key_abs >= 0)
    s = jnp.where(mask, s, NEG)
    sink = sinks.astype(jnp.float32).reshape(1, N_KV_HEADS, Q_PER_KV, 1, 1, 1)
    sink = jnp.broadcast_to(sink, s.shape[:-1] + (1,))
    p = jax.nn.softmax(jnp.concatenate([s, sink], axis=-1), axis=-1)[..., :-1]
    o = jnp.einsum('bkgnqj,bnjkd->bnqkgd', p.astype(v.dtype), vv)
    return o.reshape(B, S, ATTN_WIDTH)


def multiscale_pool(u, pool_w, pool_scale):
    B, S = u.shape[0], u.shape[1]
    ug = u.reshape(B, S, N_POOL_GROUPS, POOL_GROUP_DIM)
    uf = ug.astype(jnp.float32)
    c = jnp.pad(jnp.cumsum(uf, axis=1), ((0, 0), (1, 0), (0, 0), (0, 0)))
    t = jnp.arange(S)[:, None]
    w = jnp.array(POOL_WINDOWS, dtype=jnp.int32)[None, :]
    start = jnp.maximum(t + 1 - w, 0)
    g = jnp.arange(N_POOL_GROUPS)[None, :]
    window_sum = c[:, 1:] - c[:, start, g]
    count = jnp.minimum(t + 1, w).astype(jnp.float32)[None, :, :, None]
    pooled = (window_sum / count - uf).astype(u.dtype)
    mixed = jnp.einsum('bsgc,gcd->bsgd', pooled, pool_w)
    mixed = mixed * pool_scale.reshape(N_POOL_GROUPS, POOL_GROUP_DIM)
    return mixed.reshape(B, S, POOL_WIDTH)


def memory_cross_attention(h, mem_n, wq, wkv, wo):
    B, S = h.shape[0], h.shape[1]
    q = (h @ wq).reshape(B, S, X_HEADS, X_HEAD_DIM)
    kv = (mem_n @ wkv).reshape(B, mem_n.shape[1], 2, X_HEADS, X_HEAD_DIM)
    k, v = kv[:, :, 0], kv[:, :, 1]
    s = jnp.einsum('bshd,bmhd->bhsm', q, k).astype(jnp.float32) * (X_HEAD_DIM ** -0.5)
    p = jax.nn.softmax(s, axis=-1)
    o = jnp.einsum('bhsm,bmhd->bshd', p.astype(v.dtype), v).reshape(B, S, X_WIDTH)
    return o @ wo


def setup_inputs(seed: int = 0) -> dict:
    key = jax.random.key(seed)
    ks = jax.random.split(key, 32)
    f32 = jnp.float32
    L, D = DEPTH, D_MODEL

    def w(k, shape, fan_in):
        return jax.random.normal(k, shape, f32) * (fan_in ** -0.5)

    def gain(k, shape):
        return 1.0 + 0.05 * jax.random.normal(k, shape, f32)

    offset = jax.random.randint(ks[2], (BATCH, 1), 0, MAX_POS_OFFSET, dtype=jnp.int32)
    positions = offset + jnp.arange(SEQ, dtype=jnp.int32)[None, :]
    return {
        "x": jax.random.normal(ks[0], (BATCH, SEQ, D), f32),
        "mem": jax.random.normal(ks[1], (BATCH, N_MEM, D), f32),
        "positions": positions,
        "ffn1_norm": gain(ks[3], (L, D)),
        "ffn1_w_gate": w(ks[4], (L, D, D_FF), D),
        "ffn1_w_up": w(ks[5], (L, D, D_FF), D),
        "ffn1_w_down": w(ks[6], (L, D_FF, D), D_FF),
        "mix_norm": gain(ks[7], (L, D)),
        "w_in": w(ks[8], (L, D, IN_WIDTH), D),
        "attn_sinks": 0.5 * jax.random.normal(ks[9], (L, N_Q_HEADS), f32),
        "pool_w": w(ks[10], (L, N_POOL_GROUPS, POOL_GROUP_DIM, POOL_GROUP_DIM), POOL_GROUP_DIM),
        "pool_scale": gain(ks[11], (L, POOL_WIDTH)),
        "attn_out_norm": gain(ks[12], (L, ATTN_WIDTH)),
        "pool_out_norm": gain(ks[13], (L, POOL_WIDTH)),
        "w_out": w(ks[14], (L, MIX_WIDTH, D), MIX_WIDTH),
        "xattn_norm": gain(ks[15], (L, D)),
        "mem_norm": gain(ks[16], (L, D)),
        "xattn_wq": w(ks[17], (L, D, X_WIDTH), D),
        "xattn_wkv": w(ks[18], (L, D, 2 * X_WIDTH), D),
        "xattn_wo": w(ks[19], (L, X_WIDTH, D), X_WIDTH),
        "ffn2_norm": gain(ks[20], (L, D)),
        "ffn2_w_gate": w(ks[21], (L, D, D_FF), D),
        "ffn2_w_up": w(ks[22], (L, D, D_FF), D),
        "ffn2_w_down": w(ks[23], (L, D_FF, D), D_FF),
        "final_norm": gain(ks[24], (D,)),
    }


def reference(x, mem, positions, ffn1_norm, ffn1_w_gate, ffn1_w_up, ffn1_w_down,
              mix_norm, w_in, attn_sinks, pool_w, pool_scale, attn_out_norm, pool_out_norm,
              w_out, xattn_norm, mem_norm, xattn_wq, xattn_wkv, xattn_wo,
              ffn2_norm, ffn2_w_gate, ffn2_w_up, ffn2_w_down, final_norm):
    B, S = x.shape[0], x.shape[1]
    cos, sin = rope_tables(positions)
    for l in range(DEPTH):
        x = x + FFN_RES * swiglu(rms_norm(x, ffn1_norm[l]), ffn1_w_gate[l], ffn1_w_up[l], ffn1_w_down[l])

        h = rms_norm(x, mix_norm[l])
        proj = h @ w_in[l]
        q = proj[..., :ATTN_WIDTH].reshape(B, S, N_Q_HEADS, HEAD_DIM)
        k = proj[..., ATTN_WIDTH:ATTN_WIDTH + KV_WIDTH].reshape(B, S, N_KV_HEADS, HEAD_DIM)
        v = proj[..., ATTN_WIDTH + KV_WIDTH:ATTN_WIDTH + 2 * KV_WIDTH].reshape(B, S, N_KV_HEADS, HEAD_DIM)
        u = proj[..., ATTN_WIDTH + 2 * KV_WIDTH:]
        q = apply_rope(q, cos, sin)
        k = apply_rope(k, cos, sin)
        out_a = sliding_window_sink_attention(q, k, v, attn_sinks[l])
        out_b = multiscale_pool(u, pool_w[l], pool_scale[l])
        merged = jnp.concatenate([rms_norm(out_a, attn_out_norm[l]),
                                  rms_norm(out_b, pool_out_norm[l])], axis=-1)
        x = x + merged @ w_out[l]

        x = x + memory_cross_attention(rms_norm(x, xattn_norm[l]), rms_norm(mem, mem_norm[l]),
                                       xattn_wq[l], xattn_wkv[l], xattn_wo[l])

        x = x + FFN_RES * swiglu(rms_norm(x, ffn2_norm[l]), ffn2_w_gate[l], ffn2_w_up[l], ffn2_w_down[l])
    return rms_norm(x, final_norm)
```

```cpp
#include <hip/hip_runtime.h>
#include <hip/hip_cooperative_groups.h>
#include <cstdio>
#include <cstdint>
namespace cg = cooperative_groups;

#ifndef MK_ONE_LAUNCH
#define MK_ONE_LAUNCH 1
#endif
#ifndef PROBE_MASK
#define PROBE_MASK 0
#endif
#ifndef PROBE_PRO
#define PROBE_PRO 0
#endif
#ifndef PROBE_NSYNC
#define PROBE_NSYNC 1
#endif
#define SEAM(local_ok_) do { if ((local_ok_) && MISCW[3]) { unsigned char* wq2_ = p.ws; asm volatile("" : "+v"(wq2_)); xcd_local_barrier((unsigned*)(wq2_ + OFF_CTL), MISCW[5], 32u); } else GSYNC(); } while (0)
#define GSYNC() do { for (int s_ = 0; s_ < PROBE_NSYNC; ++s_) { if (p.ph_hi > 4096) cg::this_grid().sync(); else { XcdBarrier gb_; { unsigned char* wq_ = p.ws; asm volatile("" : "+v"(wq_)); gb_.bar = (unsigned*)(wq_ + OFF_CTL); } gb_.x = xb_xcc_id(); gb_.st = (volatile LAS unsigned*)(lds + LDS_BARST); xcd_barrier(gb_); } } } while (0)

#define LAS __attribute__((address_space(3)))
typedef unsigned short bf16_t;
typedef short bf16x8 __attribute__((ext_vector_type(8)));
typedef float f32x4 __attribute__((ext_vector_type(4)));
typedef float f32x16 __attribute__((ext_vector_type(16)));
typedef unsigned u32x4 __attribute__((ext_vector_type(4)));
typedef unsigned u32x2 __attribute__((ext_vector_type(2)));

constexpr int MT = 32768;
constexpr int SEQ = 8192;
constexpr int DM = 1024;
constexpr int FF = 2816;
constexpr int INW = 1280;
constexpr float EPS = 1e-6f;
constexpr float LOG2E = 1.4426950408889634f;
constexpr float QSCALE_SWA = 0.125f * LOG2E;
constexpr float QSCALE_X = 0.0625f * LOG2E;

constexpr size_t SLOT = 1024 * 1024;
constexpr size_t WO_GU1 = 0;
constexpr size_t WO_D1 = WO_GU1 + (size_t)5632 * 1024 * 2;
constexpr size_t WO_IN = WO_D1 + (size_t)1024 * 2816 * 2;
constexpr size_t WO_OUT = WO_IN + (size_t)1280 * 1024 * 2;
constexpr size_t WO_GU2 = WO_OUT + SLOT * 2;
constexpr size_t WO_D2 = WO_GU2 + (size_t)5632 * 1024 * 2;
constexpr size_t WO_PW = WO_D2 + (size_t)1024 * 2816 * 2;
constexpr size_t WL_BYTES = WO_PW + 4 * 128 * 128 * 2;
constexpr size_t OFF_W = 0;
constexpr size_t OFF_WQN = OFF_W + 2 * WL_BYTES;
constexpr size_t OFF_WOT = OFF_WQN + 2 * SLOT * 2;
constexpr size_t OFF_MEMN = OFF_WOT + 2 * SLOT * 2;
constexpr size_t OFF_WKV = OFF_MEMN + 2 * SLOT * 2;
constexpr size_t OFF_KVH = OFF_WKV + 4 * SLOT * 2;
constexpr size_t OFF_WQK = OFF_KVH + 64 * 65536 * 2;
constexpr size_t OFF_WVO = OFF_WQK + 8 * SLOT * 2;
constexpr size_t OFF_XB = OFF_WVO + 8 * SLOT * 2;
constexpr size_t OFF_ACT = OFF_XB + (size_t)MT * DM * 2;
constexpr size_t OFF_PROJ = OFF_ACT + (size_t)MT * FF * 2;
constexpr size_t OFF_SSQ = OFF_PROJ + (size_t)MT * INW * 2;
constexpr size_t OFF_QF = OFF_SSQ + (size_t)MT * 16 * 4;
constexpr size_t OFF_VTG = OFF_QF + (size_t)MT * 512 * 2;
constexpr size_t OFF_COS = OFF_VTG + (size_t)4 * 128 * SEQ * 2;
constexpr size_t OFF_SIN = OFF_COS + (size_t)MT * 32 * 4;
constexpr size_t OFF_CTL = OFF_SIN + (size_t)MT * 32 * 4;
constexpr size_t DO_P = 0, DO_MRG = (size_t)8 << 20;
__device__ __forceinline__ size_t drow(size_t r) { return ((r >> 12) << 23) + (r & 4095) * 1024; }
constexpr size_t CTL_BYTES = 32768;
constexpr size_t WS_END = OFF_CTL + CTL_BYTES;

constexpr int LDS_XCH = 131072;
constexpr int LDS_BARST = 131072 + 8192 + 512;
constexpr int LDS_RS = 131072 + 8192 + 1024;
constexpr int LDS_BYTES = LDS_RS + 12 * 1024;

__device__ __forceinline__ unsigned cvt_pk_bf16(float lo, float hi) { unsigned r; asm volatile("v_cvt_pk_bf16_f32 %0, %1, %2" : "=v"(r) : "v"(lo), "v"(hi)); return r; }
__device__ __forceinline__ u32x4 pair16(u32x2 we, u32x2 wo) {
    const auto a = __builtin_amdgcn_permlane32_swap(we.x, wo.x, false, false), b = __builtin_amdgcn_permlane32_swap(we.y, wo.y, false, false);
    u32x4 r; r.x = a[0]; r.y = b[0]; r.z = a[1]; r.w = b[1]; return r;
}
__device__ __forceinline__ float half_sum(float v) { const auto r = __builtin_amdgcn_permlane32_swap(__float_as_uint(v), __float_as_uint(v), false, false); return __uint_as_float(r[0]) + __uint_as_float(r[1]); }
__device__ __forceinline__ float half_max(float v) { const auto r = __builtin_amdgcn_permlane32_swap(__float_as_uint(v), __float_as_uint(v), false, false); return fmaxf(__uint_as_float(r[0]), __uint_as_float(r[1])); }
__device__ __forceinline__ float bf_lo(unsigned u) { return __uint_as_float(u << 16); }
__device__ __forceinline__ float bf_hi(unsigned u) { return __uint_as_float(u & 0xffff0000u); }
__device__ __forceinline__ float wave_sum(float v) {
#pragma unroll
    for (int o = 1; o < 64; o <<= 1) v += __shfl_xor(v, o);
    return v;
}
__device__ __forceinline__ float rs_of(f32x4 a) { return rsqrtf(((a.x + a.y) + (a.z + a.w)) * (1.0f / 1024.0f) + EPS); }
__device__ __forceinline__ float row_rs(const float* ssq, int row) {
    return rs_of(*(const f32x4*)(ssq + (size_t)row * 4));
}

constexpr int BM = 256, BK = 64, HALF = 128, HTB = HALF * BK * 2, NXCD = 8, WGM = 8;
__device__ __forceinline__ int lds_byte(int r, int c) { const int st = (r >> 4) * 2 + (c >> 5), rr = r & 15, cc = c & 31, ob = rr * 64 + cc * 2; return st * 1024 + (ob ^ (((ob >> 9) & 1) << 5)); }
__device__ __forceinline__ void stage_rc(int b, int& R, int& C) { const int st = b / 1024, sb = b % 1024, swz = sb ^ (((sb >> 9) & 1) << 5); R = (st >> 1) * 16 + swz / 64; C = (st & 1) * 32 + (swz % 64) / 2; }
__device__ __forceinline__ int perm32(int rho) { const int n = rho >> 4, i = rho & 15; return 8 * (i >> 2) + 4 * n + (i & 3); }

struct Unit { int pm, pn; };
struct Gemm { const bf16_t* A; const bf16_t* Bt; int lda, ldb, K, nM, nN, pm_div; size_t a_pm, a_b, a_pn, b_pn, b_b; int c_shift; int a_div; };
struct StaticOrder {
    int nM, nN, nwg, G, c;
    __device__ void init(int nM_, int nN_, int G_, int c_) { nM = nM_; nN = nN_; nwg = nM * nN; G = G_; c = c_; }
    __device__ bool next(int i, Unit& u) const {
        const long L = (long)i * G + c; if (L >= nwg) return false;
        int wgid = (int)L; { const int q = nwg / NXCD, r = nwg % NXCD, xcd = wgid % NXCD, off = wgid / NXCD; wgid = (xcd < r ? xcd * (q + 1) : r * (q + 1) + (xcd - r) * q) + off; }
        const int nig = WGM * nN, gid = wgid / nig, fm = gid * WGM, gsz = (nM - fm) < WGM ? (nM - fm) : WGM;
        u.pm = fm + ((wgid % nig) % gsz); u.pn = (wgid % nig) / gsz; return true;
    }
};

typedef f32x4 Acc[2][2][4][2];

struct EpiGateUp {
    static constexpr bool PERM = true, XCH = false, RS = true;
    const float* ssq; bf16_t* act;
    __device__ __forceinline__ void operator()(Acc& acc, const Unit& u, int ui, int wr, int wc, int fr, int fq, LAS unsigned char* lds) const {
        const LAS float* rsT = (const LAS float*)(lds + LDS_RS) + ui * 256 + wr * 64 + fr;
        const int row0 = u.pm * BM + wr * 64 + fr, col0 = u.pn * 128 + wc * 32 + 8 * fq;
#pragma unroll
        for (int ai = 0; ai < 2; ++ai)
#pragma unroll
            for (int m = 0; m < 4; ++m) {
                const int row = row0 + ai * HALF + m * 16; const float r = rsT[ai * HALF + m * 16];
                const float c1 = -r * LOG2E, r2 = r * r;
                float o[8];
#pragma unroll
                for (int n = 0; n < 2; ++n) { const f32x4 g = acc[ai][0][m][n], up = acc[ai][1][m][n]; const f32x4 t = g * c1;
                    f32x4 e; e.x = __builtin_amdgcn_exp2f(t.x); e.y = __builtin_amdgcn_exp2f(t.y); e.z = __builtin_amdgcn_exp2f(t.z); e.w = __builtin_amdgcn_exp2f(t.w);
                    const f32x4 d = e + 1.0f; f32x4 rc; rc.x = __builtin_amdgcn_rcpf(d.x); rc.y = __builtin_amdgcn_rcpf(d.y); rc.z = __builtin_amdgcn_rcpf(d.z); rc.w = __builtin_amdgcn_rcpf(d.w);
                    const f32x4 v = (g * up) * (rc * r2);
                    o[n * 4 + 0] = v.x; o[n * 4 + 1] = v.y; o[n * 4 + 2] = v.z; o[n * 4 + 3] = v.w; }
                u32x4 w; w.x = cvt_pk_bf16(o[0], o[1]); w.y = cvt_pk_bf16(o[2], o[3]); w.z = cvt_pk_bf16(o[4], o[5]); w.w = cvt_pk_bf16(o[6], o[7]);
                *(u32x4*)(act + (size_t)row * FF + col0) = w;
            }
    }
};
struct EpiResid {
    static constexpr bool PERM = true, XCH = false, RS = false;
    bf16_t* xb; float* ssq; float alpha;
    __device__ __forceinline__ void operator()(Acc& acc, const Unit& u, int ui, int wr, int wc, int fr, int fq, LAS unsigned char* lds) const {
        LAS float* X = (LAS float*)(lds + LDS_XCH);
        const int row0 = u.pm * BM + wr * 64 + fr, col0 = u.pn * BM + wc * 32 + 8 * fq;
#pragma unroll
        for (int ai = 0; ai < 2; ++ai)
#pragma unroll
            for (int m = 0; m < 4; ++m) {
                const int row = row0 + ai * HALF + m * 16; bf16_t* xr = xb + (size_t)row * DM + col0; float q = 0.f;
                const u32x4 x0 = *(const u32x4*)xr, x1 = *(const u32x4*)(xr + HALF);
#pragma unroll
                for (int bj = 0; bj < 2; ++bj) { const u32x4 xo = bj ? x1 : x0; float v[8];
#pragma unroll
                    for (int n = 0; n < 2; ++n) { const f32x4 a = acc[ai][bj][m][n] * alpha;
                        v[4 * n + 0] = bf_lo(xo[2 * n]) + a.x; v[4 * n + 1] = bf_hi(xo[2 * n]) + a.y; v[4 * n + 2] = bf_lo(xo[2 * n + 1]) + a.z; v[4 * n + 3] = bf_hi(xo[2 * n + 1]) + a.w; }
#pragma unroll
                    for (int j = 0; j < 8; ++j) q += v[j] * v[j];
                    u32x4 w; w.x = cvt_pk_bf16(v[0], v[1]); w.y = cvt_pk_bf16(v[2], v[3]); w.z = cvt_pk_bf16(v[4], v[5]); w.w = cvt_pk_bf16(v[6], v[7]);
                    *(u32x4*)(xr + bj * HALF) = w; }
                q += __shfl_xor(q, 16); q += __shfl_xor(q, 32);
                if (fq == 0) X[(ai * HALF + wr * 64 + m * 16 + fr) * 4 + wc] = q;
            }
        asm volatile("s_waitcnt lgkmcnt(0)" ::: "memory"); __builtin_amdgcn_s_barrier(); asm volatile("" ::: "memory");
        const int t = (wr * 4 + wc) * 64 + fq * 16 + fr;
        if (t < 256) { const f32x4 v = *(const LAS f32x4*)(X + t * 4); ssq[(size_t)(u.pm * BM + t) * 4 + u.pn] = (v.x + v.y) + (v.z + v.w); }
        asm volatile("s_waitcnt lgkmcnt(0)" ::: "memory");
    }
};
struct EpiWin {
    static constexpr bool PERM = true, XCH = false, RS = true;
    const float* ssq; const float* cs; const float* sn; bf16_t* proj; bf16_t* qf; bf16_t* vtg;
    __device__ __forceinline__ void operator()(Acc& acc, const Unit& u, int ui, int wr, int wc, int fr, int fq, LAS unsigned char* lds) const {
        const LAS float* rsT = (const LAS float*)(lds + LDS_RS) + ui * 256 + wr * 64 + fr;
        const int row0 = u.pm * BM + wr * 64 + fr, tile = u.pn;
        const bool rope = (tile < 2) || (tile == 2 && wc < 2);
#pragma unroll
        for (int ai = 0; ai < 2; ++ai)
#pragma unroll
            for (int m = 0; m < 4; ++m) {
                const int row = row0 + ai * HALF + m * 16; float r = rsT[ai * HALF + m * 16];
                bf16_t* prow = proj + (size_t)row * INW;
                float o0[8], o1[8]; int c0, c1;
                if (rope) {
                    if (tile < 2) r *= QSCALE_SWA;
                    const f32x4 ca = *(const f32x4*)(cs + (size_t)row * 32 + 8 * fq), cb = *(const f32x4*)(cs + (size_t)row * 32 + 8 * fq + 4);
                    const f32x4 sa = *(const f32x4*)(sn + (size_t)row * 32 + 8 * fq), sb = *(const f32x4*)(sn + (size_t)row * 32 + 8 * fq + 4);
#pragma unroll
                    for (int n = 0; n < 2; ++n)
#pragma unroll
                        for (int j = 0; j < 4; ++j) { const float x1 = acc[ai][0][m][n][j] * r, x2 = acc[ai][1][m][n][j] * r; const float c = n ? cb[j] : ca[j], s = n ? sb[j] : sa[j];
                            o0[n * 4 + j] = x1 * c - x2 * s; o1[n * 4 + j] = x2 * c + x1 * s; }
                    c0 = (tile < 2 ? tile * 256 : 512) + wc * 64 + 8 * fq; c1 = c0 + 32;
                } else {
#pragma unroll
                    for (int n = 0; n < 2; ++n)
#pragma unroll
                        for (int j = 0; j < 4; ++j) { o0[n * 4 + j] = acc[ai][0][m][n][j] * r; o1[n * 4 + j] = acc[ai][1][m][n][j] * r; }
                    if (tile == 2) { c0 = 640 + 32 * (wc - 2) + 8 * fq; c1 = c0 + 64; }
                    else { c0 = tile * 256 + wc * 32 + 8 * fq; c1 = c0 + 128; }
                }
                u32x4 w0, w1; w0.x = cvt_pk_bf16(o0[0], o0[1]); w0.y = cvt_pk_bf16(o0[2], o0[3]); w0.z = cvt_pk_bf16(o0[4], o0[5]); w0.w = cvt_pk_bf16(o0[6], o0[7]);
                w1.x = cvt_pk_bf16(o1[0], o1[1]); w1.y = cvt_pk_bf16(o1[2], o1[3]); w1.z = cvt_pk_bf16(o1[4], o1[5]); w1.w = cvt_pk_bf16(o1[6], o1[7]);
                if (tile < 2) {
                    bf16_t* qb = qf + ((((size_t)(row >> 5) * 8 + tile * 4 + wc) * 4 + (fq >> 1)) * 2 + (fq & 1)) * 256 + (size_t)(row & 31) * 8;
                    *(u32x4*)qb = w0; *(u32x4*)(qb + 2 * 2 * 256) = w1;
                } else if (tile == 2 && wc >= 2) {
                    bf16_t* vb = vtg + ((size_t)(row >> 13) * 128 + 32 * (wc - 2) + 8 * fq) * SEQ + (row & (SEQ - 1));
#pragma unroll
                    for (int e = 0; e < 4; ++e) { vb[(size_t)(2 * e) * SEQ] = (bf16_t)(w0[e] & 0xffffu); vb[(size_t)(2 * e + 1) * SEQ] = (bf16_t)(w0[e] >> 16);
                        vb[(size_t)(64 + 2 * e) * SEQ] = (bf16_t)(w1[e] & 0xffffu); vb[(size_t)(64 + 2 * e + 1) * SEQ] = (bf16_t)(w1[e] >> 16); }
                } else { *(u32x4*)(prow + c0) = w0; *(u32x4*)(prow + c1) = w1; }
            }
    }
};
struct EpiBf16 {
    static constexpr bool PERM = true, XCH = false, RS = false;
    bf16_t* out; size_t tb_pm, tb_pn; int ldc, mode; float scale;
    __device__ __forceinline__ void operator()(Acc& acc, const Unit& u, int ui, int wr, int wc, int fr, int fq, LAS unsigned char*) const {
        size_t tb = (size_t)u.pm * tb_pm + (size_t)u.pn * tb_pn;
        if (mode) tb = (size_t)((u.pn >> 2) * 32 + ((u.pm >> 2) * 4 + (u.pn & 3)) * 4 + (u.pm & 3)) * 65536;
        bf16_t* o = out + tb + (size_t)(wr * 64 + fr) * ldc + wc * 32 + 8 * fq;
#pragma unroll
        for (int ai = 0; ai < 2; ++ai)
#pragma unroll
            for (int m = 0; m < 4; ++m) {
#pragma unroll
                for (int bj = 0; bj < 2; ++bj) { const f32x4 v0 = acc[ai][bj][m][0] * scale, v1 = acc[ai][bj][m][1] * scale;
                    u32x4 w; w.x = cvt_pk_bf16(v0.x, v0.y); w.y = cvt_pk_bf16(v0.z, v0.w); w.z = cvt_pk_bf16(v1.x, v1.y); w.w = cvt_pk_bf16(v1.z, v1.w);
                    *(u32x4*)(o + (size_t)(ai * HALF + m * 16) * ldc + bj * HALF) = w; }
            }
    }
};
struct EpiSoftmax {
    static constexpr bool PERM = true, XCH = true, RS = true;
    const float* ssq; bf16_t* out; int ldc;
    __device__ __forceinline__ void operator()(Acc& acc, const Unit& u, int ui, int wr, int wc, int fr, int fq, LAS unsigned char* lds) const {
        const LAS float* rsT = (const LAS float*)(lds + LDS_RS) + ui * 256 + wr * 64 + fr;
        typedef float f32x2v __attribute__((ext_vector_type(2)));
        LAS f32x2v* X = (LAS f32x2v*)(lds + LDS_XCH);
        float mw[2][4];
#pragma unroll
        for (int ai = 0; ai < 2; ++ai)
#pragma unroll
            for (int m = 0; m < 4; ++m) {
                float mx = -3.0e38f; const float r = rsT[ai * HALF + m * 16];
#pragma unroll
                for (int bj = 0; bj < 2; ++bj)
#pragma unroll
                    for (int n = 0; n < 2; ++n) { const f32x4 v = acc[ai][bj][m][n] * r; acc[ai][bj][m][n] = v; mx = fmaxf(mx, fmaxf(fmaxf(v.x, v.y), fmaxf(v.z, v.w))); }
                mx = fmaxf(mx, __shfl_xor(mx, 16)); mx = fmaxf(mx, __shfl_xor(mx, 32));
                float s = 0.f;
#pragma unroll
                for (int bj = 0; bj < 2; ++bj)
#pragma unroll
                    for (int n = 0; n < 2; ++n) { f32x4 v = acc[ai][bj][m][n];
                        v.x = __builtin_amdgcn_exp2f(v.x - mx); v.y = __builtin_amdgcn_exp2f(v.y - mx); v.z = __builtin_amdgcn_exp2f(v.z - mx); v.w = __builtin_amdgcn_exp2f(v.w - mx);
                        s += (v.x + v.y) + (v.z + v.w); acc[ai][bj][m][n] = v; }
                s += __shfl_xor(s, 16); s += __shfl_xor(s, 32);
                mw[ai][m] = mx;
                if (fq == 0) X[(ai * HALF + wr * 64 + m * 16 + fr) * 4 + wc] = (f32x2v){mx, s};
            }
        asm volatile("s_waitcnt lgkmcnt(0)" ::: "memory"); __builtin_amdgcn_s_barrier(); asm volatile("" ::: "memory");
        const int row0 = u.pm * BM + wr * 64 + fr, col0 = u.pn * BM + wc * 32 + 8 * fq;
#pragma unroll
        for (int ai = 0; ai < 2; ++ai)
#pragma unroll
            for (int m = 0; m < 4; ++m) {
                const int rl = ai * HALF + wr * 64 + m * 16 + fr;
                const f32x2v a = X[rl * 4 + 0], b = X[rl * 4 + 1], c = X[rl * 4 + 2], d = X[rl * 4 + 3];
                const float M = fmaxf(fmaxf(a.x, b.x), fmaxf(c.x, d.x));
                const float L = (a.y * __builtin_amdgcn_exp2f(a.x - M) + b.y * __builtin_amdgcn_exp2f(b.x - M)) + (c.y * __builtin_amdgcn_exp2f(c.x - M) + d.y * __builtin_amdgcn_exp2f(d.x - M));
                const float f = __builtin_amdgcn_exp2f(mw[ai][m] - M) / L;
                const int row = row0 + ai * HALF + m * 16;
#pragma unroll
                for (int bj = 0; bj < 2; ++bj) { const f32x4 v0 = acc[ai][bj][m][0] * f, v1 = acc[ai][bj][m][1] * f;
                    u32x4 w; w.x = cvt_pk_bf16(v0.x, v0.y); w.y = cvt_pk_bf16(v0.z, v0.w); w.z = cvt_pk_bf16(v1.x, v1.y); w.w = cvt_pk_bf16(v1.z, v1.w);
                    *(u32x4*)(out + drow((size_t)row) + col0 + bj * HALF) = w; }
            }
        asm volatile("s_waitcnt lgkmcnt(0)" ::: "memory");
    }
};

template <class Epi>
__device__ __forceinline__ void gemm_phase(LAS unsigned char* lds, const Gemm g, const Epi& E) {
    constexpr bool ALIGN_EPI = true;
    int tid_ = threadIdx.x; asm volatile("" : "+v"(tid_));
    const int tid = tid_, wid = __builtin_amdgcn_readfirstlane(tid >> 6), lane = tid & 63, wr = wid >> 2, wc = wid & 3, fr = lane & 15, fq = lane >> 4;
    const int nt = g.K / BK;
    const unsigned vcu = ((volatile LAS unsigned*)(lds + LDS_BARST))[2];
    StaticOrder S; S.init(g.nM, g.nN, (int)gridDim.x, (int)((vcu + gridDim.x - (unsigned)g.c_shift % gridDim.x) % gridDim.x));
    unsigned voffA[2], voffB[2];
#pragma unroll
    for (int i = 0; i < 2; ++i) { int R, C; stage_rc(tid * 16 + i * 8192, R, C); const int Rb = Epi::PERM ? ((R & ~31) + perm32(R & 31)) : R;
        voffA[i] = (unsigned)(R * g.lda + C) * 2u; voffB[i] = (unsigned)(Rb * g.ldb + C) * 2u; }
    const size_t kstep = (size_t)(BK * 2);
    const size_t hstepA = (size_t)HALF * g.lda * 2, hstepB = (size_t)HALF * g.ldb * 2;
    const unsigned ldsw = (unsigned)wid * 1024u;
    const int aoff = lds_byte(wr * 64 + fr, fq * 8), boff = lds_byte(wc * 32 + fr, fq * 8);
#define G_ABASE(u) ((const char*)(g.A + (size_t)((u).pm % (g.a_div ? g.a_div : g.pm_div)) * g.a_pm + (size_t)((u).pm / (g.a_div ? g.a_div : g.pm_div)) * g.a_b + (size_t)(u).pn * g.a_pn))
#define G_BBASE(u) ((const char*)(g.Bt + (size_t)(u).pn * g.b_pn + (size_t)((u).pm / g.pm_div) * g.b_b))
#define PG8_SA(b, h) (((b) * 2 + (h)) * HTB)
#define PG8_SB(b, h) ((4 + (b) * 2 + (h)) * HTB)
#define PG8_STAGE(bufoff, gbase, voff) do { _Pragma("unroll") for (int _i = 0; _i < 2; ++_i) \
        __builtin_amdgcn_global_load_lds((const unsigned*)((const char*)(gbase) + (voff)[_i]), (LAS unsigned*)(lds + (bufoff) + ldsw + _i * 8192), 16, 0, 0); } while (0)
#define PG8_LDA(dst, b, h) do { _Pragma("unroll") for (int m = 0; m < 4; ++m) _Pragma("unroll") for (int k = 0; k < 2; ++k) dst[m][k] = *(const LAS bf16x8*)(lds + PG8_SA(b, h) + aoff + m * 2048 + k * 1024); } while (0)
#define PG8_LDB(dst, b, h) do { _Pragma("unroll") for (int n = 0; n < 2; ++n) _Pragma("unroll") for (int k = 0; k < 2; ++k) dst[n][k] = *(const LAS bf16x8*)(lds + PG8_SB(b, h) + boff + n * 2048 + k * 1024); } while (0)
#define PG8_MMA(ai, bj, At, Bt) do { __builtin_amdgcn_s_setprio(1); _Pragma("unroll") for (int m = 0; m < 4; ++m) _Pragma("unroll") for (int n = 0; n < 2; ++n) _Pragma("unroll") for (int k = 0; k < 2; ++k) \
        acc[ai][bj][m][n] = __builtin_amdgcn_mfma_f32_16x16x32_bf16(Bt[n][k], At[m][k], acc[ai][bj][m][n], 0, 0, 0); __builtin_amdgcn_s_setprio(0); } while (0)
#define PG8_WAIT_V(n) asm volatile("s_waitcnt vmcnt(" #n ")" ::: "memory")
#define PG8_WAIT_L(n) asm volatile("s_waitcnt lgkmcnt(" #n ")" ::: "memory")
#define PG8_BAR __builtin_amdgcn_s_barrier()
#define PG8_SCHED __builtin_amdgcn_sched_barrier(0)
    Unit cur, nxt; int ui = 0;
    if (!S.next(0, cur)) return;
    Acc acc;
#pragma unroll
    for (int a = 0; a < 2; ++a)
#pragma unroll
        for (int b = 0; b < 2; ++b)
#pragma unroll
            for (int m = 0; m < 4; ++m)
#pragma unroll
                for (int n = 0; n < 2; ++n) acc[a][b][m][n] = (f32x4){0.f, 0.f, 0.f, 0.f};
    bf16x8 At[4][2], B0[2][2], B1[2][2];
    const char* cA = G_ABASE(cur); const char* cB = G_BBASE(cur);
    PG8_STAGE(PG8_SB(0, 0), cB, voffB); PG8_STAGE(PG8_SB(0, 1), cB + hstepB, voffB); PG8_STAGE(PG8_SA(0, 0), cA, voffA); PG8_STAGE(PG8_SA(0, 1), cA + hstepA, voffA);
    if constexpr (Epi::RS) {
        f32x4 pv[6]; bool ok[6];
#pragma unroll
        for (int j = 0; j < 6; ++j) { Unit tu; ok[j] = S.next((tid >> 8) + 2 * j, tu); pv[j] = (f32x4){0.f, 0.f, 0.f, 0.f}; if (ok[j]) pv[j] = *(const f32x4*)(E.ssq + (size_t)(tu.pm * BM + (tid & 255)) * 4); }
#pragma unroll
        for (int j = 0; j < 6; ++j) if (ok[j]) ((LAS float*)(lds + LDS_RS))[((tid >> 8) + 2 * j) * 256 + (tid & 255)] = rs_of(pv[j]);
        asm volatile("s_waitcnt lgkmcnt(0)" ::: "memory"); __builtin_amdgcn_s_barrier(); asm volatile("" ::: "memory");
    }
    if (wr == 1) PG8_BAR;
    PG8_WAIT_V(2); PG8_BAR;
    PG8_STAGE(PG8_SB(1, 0), cB + kstep, voffB); PG8_STAGE(PG8_SA(1, 0), cA + kstep, voffA); PG8_STAGE(PG8_SB(1, 1), cB + hstepB + kstep, voffB);
    PG8_WAIT_V(6); PG8_BAR;
    for (;;) {
        const bool has_next = S.next(ui + 1, nxt);
        const char* nA = has_next ? G_ABASE(nxt) : cA; const char* nB = has_next ? G_BBASE(nxt) : cB;
        for (int t = 0; t < nt; t += 2) {
            const bool last = (t == nt - 2);
            const char* a1 = cA + (size_t)(t + 1) * kstep;
            const char* a2 = last ? nA : cA + (size_t)(t + 2) * kstep; const char* b2 = last ? nB : cB + (size_t)(t + 2) * kstep;
            const char* a3 = a2 + kstep; const char* b3 = b2 + kstep;
            PG8_LDB(B0, 0, 0); PG8_LDB(B1, 0, 1); PG8_SCHED; PG8_LDA(At, 0, 0); PG8_STAGE(PG8_SA(1, 1), a1 + hstepA, voffA);
            PG8_WAIT_V(8); PG8_WAIT_L(0); PG8_BAR; PG8_MMA(0, 0, At, B0); PG8_MMA(0, 1, At, B1); PG8_BAR; PG8_SCHED;
            PG8_LDA(At, 0, 1); PG8_STAGE(PG8_SB(0, 0), b2, voffB); PG8_STAGE(PG8_SB(0, 1), b2 + hstepB, voffB); PG8_STAGE(PG8_SA(0, 0), a2, voffA);
            PG8_WAIT_V(8); PG8_WAIT_L(0); PG8_BAR; PG8_MMA(1, 0, At, B0); PG8_MMA(1, 1, At, B1); PG8_BAR; PG8_SCHED;
            PG8_LDB(B0, 1, 0); PG8_LDB(B1, 1, 1); PG8_SCHED; PG8_LDA(At, 1, 0); PG8_STAGE(PG8_SA(0, 1), a2 + hstepA, voffA);
            PG8_WAIT_V(8); PG8_WAIT_L(0); PG8_BAR; PG8_MMA(0, 0, At, B0); PG8_MMA(0, 1, At, B1); PG8_BAR; PG8_SCHED;
            PG8_LDA(At, 1, 1); PG8_STAGE(PG8_SB(1, 0), b3, voffB); PG8_STAGE(PG8_SB(1, 1), b3 + hstepB, voffB); PG8_STAGE(PG8_SA(1, 0), a3, voffA);
            PG8_WAIT_V(8); PG8_WAIT_L(0); PG8_BAR; PG8_MMA(1, 0, At, B0); PG8_MMA(1, 1, At, B1); PG8_BAR; PG8_SCHED;
        }
        if constexpr (ALIGN_EPI) { if (wr == 0) PG8_BAR; }
        E(acc, cur, ui, wr, wc, fr, fq, lds);
        if (!has_next) break;
#pragma unroll
        for (int a = 0; a < 2; ++a)
#pragma unroll
            for (int b = 0; b < 2; ++b)
#pragma unroll
                for (int m = 0; m < 4; ++m)
#pragma unroll
                    for (int n = 0; n < 2; ++n) acc[a][b][m][n] = (f32x4){0.f, 0.f, 0.f, 0.f};
        cur = nxt; cA = nA; cB = nB; ++ui;
        if constexpr (ALIGN_EPI) { if (wr == 1) PG8_BAR; }
    }
    PG8_WAIT_V(0);
    if constexpr (!ALIGN_EPI) { if (wr == 0) PG8_BAR; }
    PG8_BAR;
#undef G_ABASE
#undef G_BBASE
#undef PG8_SA
#undef PG8_SB
#undef PG8_STAGE
#undef PG8_LDA
#undef PG8_LDB
#undef PG8_MMA
#undef PG8_WAIT_V
#undef PG8_WAIT_L
#undef PG8_BAR
#undef PG8_SCHED
}

enum { MAP_ID = 0, MAP_GATE = 1, MAP_UP = 2, MAP_WIN = 3 };
__device__ __forceinline__ int map_row(int kind, int n) {
    if (kind == MAP_GATE) return 256 * (n >> 7) + (n & 127);
    if (kind == MAP_UP) return 256 * (n >> 7) + 128 + (n & 127);
    if (kind == MAP_WIN) {
        if (n < 512) { const int head = n >> 6, d = n & 63, tile = head >> 2, hh = head & 3; return 256 * tile + (d < 32 ? 32 * hh + d : 128 + 32 * hh + d - 32); }
        if (n < 640) { const int kh = (n - 512) >> 6, d = n & 63; return 512 + (d < 32 ? 32 * kh + d : 128 + 32 * kh + d - 32); }
        if (n < 768) { const int vc = n - 640; return 512 + (vc < 64 ? 64 + vc : 128 + 64 + (vc - 64)); }
        return n;
    }
    return n;
}
__device__ __forceinline__ void conv_item(const float* W, const float* gain, int K, int N, bf16_t* WT, int kind, bool hm, LAS float* scr, int item, int lane) {
    const int nblk = N / 32, kb = item / nblk, nb = item % nblk, k0 = 64 * kb, n0 = 32 * nb;
    {
        const int kr = lane >> 3, c4 = lane & 7; f32x4 v[8]; float gv[8];
#pragma unroll
        for (int i = 0; i < 8; ++i) { v[i] = *(const f32x4*)(W + (size_t)(k0 + 8 * i + kr) * N + n0 + 4 * c4); gv[i] = gain ? gain[k0 + 8 * i + kr] : 1.0f; }
#pragma unroll
        for (int i = 0; i < 8; ++i) { LAS float* d = scr + (8 * i + kr) * 33 + 4 * c4; d[0] = v[i].x * gv[i]; d[1] = v[i].y * gv[i]; d[2] = v[i].z * gv[i]; d[3] = v[i].w * gv[i]; }
    }
    asm volatile("s_waitcnt lgkmcnt(0)" ::: "memory");
    const int c = lane & 7;
#pragma unroll
    for (int j = 0; j < 4; ++j) { const int n = (lane >> 3) + 8 * j; const LAS float* s = scr + (8 * c) * 33 + n;
        u32x4 o; o.x = cvt_pk_bf16(s[0 * 33], s[1 * 33]); o.y = cvt_pk_bf16(s[2 * 33], s[3 * 33]); o.z = cvt_pk_bf16(s[4 * 33], s[5 * 33]); o.w = cvt_pk_bf16(s[6 * 33], s[7 * 33]);
        const int kc = k0 + 8 * c; bf16_t* dp = hm ? WT + ((size_t)(kc >> 8) * N + n0 + n) * 256 + (kc & 255) : WT + (size_t)map_row(kind, n0 + n) * K + kc;
        *(u32x4*)dp = o; }
    asm volatile("s_waitcnt lgkmcnt(0)" ::: "memory");
}

struct Params { const float* in[25]; float* out; unsigned char* ws; int ph_lo, ph_hi; };

__device__ __forceinline__ void prologue(const Params& p, LAS unsigned char* lds) {
    int tid_ = threadIdx.x; asm volatile("" : "+v"(tid_));
    const int tid = tid_, lane = tid & 63, wave = __builtin_amdgcn_readfirstlane(tid >> 6);
    LAS float* scr = (LAS float*)(lds + wave * 16384);
    const int gw = blockIdx.x * 8 + wave, NGW = gridDim.x * 8;
    unsigned char* ws = p.ws;
    constexpr int IPL = 1408 * 6 + 640 + 512 * 2 + 1024 + 32;
    for (int it = gw; it < 2 * IPL; it += NGW) {
        const int l = it / IPL; int r = it % IPL; size_t wl_extra = 0;
        unsigned char* wl = ws + OFF_W + (size_t)l * WL_BYTES;
        int wi, gi = -1, K = 1024, N = 1024, kind = MAP_ID; size_t wstride = SLOT, doff; bool in_wl = true, hm = false;
        if (r < 1408) { wi = 4; gi = 3; N = FF; kind = MAP_GATE; wstride = (size_t)DM * FF; doff = WO_GU1; }
        else if ((r -= 1408) < 1408) { wi = 5; gi = 3; N = FF; kind = MAP_UP; wstride = (size_t)DM * FF; doff = WO_GU1; }
        else if ((r -= 1408) < 1408) { wi = 6; K = FF; wstride = (size_t)DM * FF; doff = WO_D1; }
        else if ((r -= 1408) < 640) { wi = 8; gi = 7; N = INW; kind = MAP_WIN; wstride = (size_t)DM * INW; doff = WO_IN; }
        else if ((r -= 640) < 512) { wi = 14; doff = WO_OUT; }
        else if ((r -= 512) < 1024) { wi = 18; N = 2048; wstride = 2 * SLOT; in_wl = false; doff = OFF_WKV + (size_t)l * 2 * SLOT * 2; }
        else if ((r -= 1024) < 512) { wi = 19; in_wl = false; hm = true; doff = OFF_WOT + (size_t)l * SLOT * 2; }
        else if ((r -= 512) < 1408) { wi = 21; gi = 20; N = FF; kind = MAP_GATE; wstride = (size_t)DM * FF; doff = WO_GU2; }
        else if ((r -= 1408) < 1408) { wi = 22; gi = 20; N = FF; kind = MAP_UP; wstride = (size_t)DM * FF; doff = WO_GU2; }
        else if ((r -= 1408) < 1408) { wi = 23; K = FF; wstride = (size_t)DM * FF; doff = WO_D2; }
        else { r -= 1408; const int g4 = r >> 3; r &= 7; wi = 10; K = 128; N = 128; wstride = 4 * 128 * 128; doff = WO_PW + (size_t)g4 * 128 * 128 * 2; wl_extra = (size_t)g4 * 128 * 128; }
        const float* W = (wi == 4 ? p.in[4] : wi == 5 ? p.in[5] : wi == 6 ? p.in[6] : wi == 8 ? p.in[8] : wi == 14 ? p.in[14] : wi == 18 ? p.in[18] : wi == 19 ? p.in[19] : wi == 21 ? p.in[21] : wi == 22 ? p.in[22] : wi == 23 ? p.in[23] : p.in[10]) + (size_t)l * wstride + wl_extra;
        const float* gain = gi < 0 ? nullptr : (gi == 3 ? p.in[3] : gi == 7 ? p.in[7] : p.in[20]) + l * DM;
        bf16_t* dst = (bf16_t*)((in_wl ? wl : ws) + doff);
        conv_item(W, gain, K, N, dst, kind, hm, scr, r, lane);
    }
    for (int it = gw; it < 2 * 1024; it += NGW) {
        const int l = it >> 10, row = it & 1023;
        const f32x4* xr = (const f32x4*)(p.in[1] + (size_t)row * DM) + lane; const f32x4* gr = (const f32x4*)(p.in[16] + l * DM) + lane;
        f32x4 v[4]; float s = 0.f;
#pragma unroll
        for (int j = 0; j < 4; ++j) { v[j] = xr[64 * j]; s += (v[j].x * v[j].x + v[j].y * v[j].y) + (v[j].z * v[j].z + v[j].w * v[j].w); }
        const float r = rsqrtf(wave_sum(s) * (1.0f / 1024.0f) + EPS);
        bf16_t* oa = (bf16_t*)(ws + OFF_MEMN) + (size_t)l * SLOT + (size_t)row * DM;
#pragma unroll
        for (int j = 0; j < 4; ++j) { const f32x4 g = gr[64 * j]; u32x2 w; w.x = cvt_pk_bf16(v[j].x * r * g.x, v[j].y * r * g.y); w.y = cvt_pk_bf16(v[j].z * r * g.z, v[j].w * r * g.w);
            *((u32x2*)oa + lane + 64 * j) = w; }
    }
    for (int it = gw; it < 2 * 1024; it += NGW) {
        const int l = it >> 10, k = it & 1023;
        const f32x4* xr = (const f32x4*)(p.in[17] + (size_t)l * SLOT + (size_t)k * DM) + lane; const float g = p.in[15][l * DM + k];
        bf16_t* o = (bf16_t*)(ws + OFF_WQN) + (size_t)l * SLOT + (size_t)k * 256;
#pragma unroll
        for (int j = 0; j < 4; ++j) { const f32x4 v = xr[64 * j]; u32x2 w; w.x = cvt_pk_bf16(v.x * g, v.y * g); w.y = cvt_pk_bf16(v.z * g, v.w * g);
            *((u32x2*)(o + (size_t)j * 1024 * 256) + lane) = w; }
    }
    for (int rb = gw * 4; rb < MT; rb += NGW * 4) {
        f32x4 v[4][4];
#pragma unroll
        for (int q = 0; q < 4; ++q) { const f32x4* xr = (const f32x4*)(p.in[0] + (size_t)(rb + q) * DM) + lane;
#pragma unroll
            for (int j = 0; j < 4; ++j) v[q][j] = xr[64 * j]; }
#pragma unroll
        for (int q = 0; q < 4; ++q) { float s = 0.f;
#pragma unroll
            for (int j = 0; j < 4; ++j) s += (v[q][j].x * v[q][j].x + v[q][j].y * v[q][j].y) + (v[q][j].z * v[q][j].z + v[q][j].w * v[q][j].w);
            s = wave_sum(s);
            bf16_t* o = (bf16_t*)(ws + OFF_XB) + (size_t)(rb + q) * DM;
#pragma unroll
            for (int j = 0; j < 4; ++j) { u32x2 w; w.x = cvt_pk_bf16(v[q][j].x, v[q][j].y); w.y = cvt_pk_bf16(v[q][j].z, v[q][j].w); *((u32x2*)o + lane + 64 * j) = w; }
            if (lane < 4) ((float*)(ws + OFF_SSQ))[(size_t)(rb + q) * 4 + lane] = (lane == 0) ? s : 0.f; }
    }
    {
        const int* pos = (const int*)p.in[2]; float* cs = (float*)(ws + OFF_COS); float* sn = (float*)(ws + OFF_SIN);
        const int gt = blockIdx.x * 512 + tid, NGT = gridDim.x * 512;
        for (int i = gt; i < MT * 32; i += NGT) { const int row = i >> 5, f = i & 31;
            const float inv = powf(10000.0f, -(float)(2 * f) / 64.0f); const float ang = (float)pos[row] * inv;
            cs[i] = cosf(ang); sn[i] = sinf(ang); }
    }
}

constexpr int MX_KS = 0, MX_KSTR = 272, MX_VT = 160 * 272, MX_VSTR = 328, MX_XA = 86016, MX_XB = 87040;
constexpr int MX_US = 88064, MX_PL = 0, MX_PSTR = 1040;
static_assert(MX_VT + 128 * MX_VSTR <= MX_XA && MX_PL + 32 * MX_PSTR <= MX_VT && MX_US + 47 * 1024 <= LDS_BYTES, "mixer LDS map");
__device__ __forceinline__ int crow(int r, int hi) { return (r & 3) + 8 * (r >> 2) + 4 * hi; }

template <int W> __device__ __forceinline__ void pool_w(const LAS unsigned* U, LAS unsigned char* pl, int t0, int ts, int cp) {
    unsigned uu[16 + W - 1];
#pragma unroll
    for (int i = 0; i < 16 + W - 1; ++i) uu[i] = U[(ts + 15 - (W - 1) + i) * 256];
    float s0 = 0.f, s1 = 0.f;
#pragma unroll
    for (int i = 0; i < W - 1; ++i) { s0 += bf_lo(uu[i]); s1 += bf_hi(uu[i]); }
#pragma unroll
    for (int t = 0; t < 16; ++t) {
        const float c0 = bf_lo(uu[W - 1 + t]), c1 = bf_hi(uu[W - 1 + t]); s0 += c0; s1 += c1;
        const int tp = t0 + ts + t + 1; const float inv = (tp < W) ? 1.0f / (float)tp : 1.0f / (float)W;
        *(LAS unsigned*)(pl + (ts + t) * MX_PSTR + cp * 4) = cvt_pk_bf16(s0 * inv - c0, s1 * inv - c1);
        s0 -= bf_lo(uu[t]); s1 -= bf_hi(uu[t]);
    }
}
constexpr int MX_TAB = LDS_RS;
static_assert(MX_TAB + 3 * 2048 <= LDS_BYTES && MX_US + 47 * 1024 <= LDS_BARST && MX_TAB > LDS_BARST + 16, "mixer LDS map (tables)");

#define MX_BAR() do { asm volatile("s_waitcnt lgkmcnt(0)" ::: "memory"); __builtin_amdgcn_s_barrier(); asm volatile("" ::: "memory"); } while (0)
__device__ __forceinline__ void mixer_phase(LAS unsigned char* lds, const bf16_t* proj, const bf16_t* qfg, const bf16_t* vtg, bf16_t* mrg, const bf16_t* pwT, const float* sinks, const float* gA, const float* gB, const float* pscale) {
    int tid_ = threadIdx.x;
    {
        asm volatile("" : "+v"(tid_));
        LAS float* tab = (LAS float*)(lds + MX_TAB);
        tab[tid_] = gA[tid_]; tab[512 + tid_] = gB[tid_]; tab[1024 + tid_] = pscale[tid_];
    }
    const int vcu = (int)((volatile LAS unsigned*)(lds + LDS_BARST))[2];
    for (int unit0 = vcu; unit0 < MT / 32; unit0 += gridDim.x) {
        const int unit = (gridDim.x == 256) ? 128 * (vcu & 7) + (vcu >> 3) + 32 * (unit0 >> 8) : unit0;
        asm volatile("" : "+v"(tid_));
        const int tid = tid_, lane = tid & 63, wid = __builtin_amdgcn_readfirstlane(tid >> 6), r32 = lane & 31, hi = lane >> 5;
        const int b = unit >> 8, t0 = (unit & 255) * 32; const size_t row0 = (size_t)b * SEQ + t0;
#pragma unroll
        for (int i = 0; i < 5; ++i) { const int idx = tid + 512 * i, key = idx >> 4, ch = idx & 15; u32x4 v = (u32x4){0u, 0u, 0u, 0u};
            if (t0 - 128 + key >= 0) v = *(const u32x4*)(proj + (row0 - 128 + key) * INW + 512 + ch * 8);
            *(LAS u32x4*)(lds + MX_KS + key * MX_KSTR + ch * 16) = v; }
#pragma unroll
        for (int i = 0; i < 5; ++i) { const int idx = tid + 512 * i, chn = idx / 20, key0 = (idx % 20) * 8; u32x4 v = (u32x4){0u, 0u, 0u, 0u};
            if (t0 - 128 + key0 >= 0) v = *(const u32x4*)(vtg + ((size_t)b * 128 + chn) * SEQ + (t0 - 128 + key0));
            LAS u32x2* vt = (LAS u32x2*)(lds + MX_VT + chn * MX_VSTR + key0 * 2); vt[0] = (u32x2){v.x, v.y}; vt[1] = (u32x2){v.z, v.w}; }
#pragma unroll
        for (int i = 0; i < 6; ++i) { const int idx = tid + 512 * i; if (idx < 47 * 64) { const int lr = idx >> 6, ch = idx & 63; u32x4 v = (u32x4){0u, 0u, 0u, 0u};
                if (t0 + lr - 15 >= 0) v = *(const u32x4*)(proj + (row0 + lr - 15) * INW + 768 + ch * 8);
                *(LAS u32x4*)(lds + MX_US + lr * 1024 + ch * 16) = v; } }
        bf16x8 qf[4];
#pragma unroll
        for (int ks = 0; ks < 4; ++ks) qf[ks] = *(const bf16x8*)(qfg + ((((size_t)unit * 8 + wid) * 4 + ks) * 2 + hi) * 256 + r32 * 8);
        MX_BAR();
        const int kvh = wid >> 2;
        f32x16 s[5];
#pragma unroll
        for (int kt = 0; kt < 5; ++kt) {
            f32x16 a = (f32x16){0.f, 0.f, 0.f, 0.f, 0.f, 0.f, 0.f, 0.f, 0.f, 0.f, 0.f, 0.f, 0.f, 0.f, 0.f, 0.f};
#pragma unroll
            for (int ks = 0; ks < 4; ++ks) { const bf16x8 kf = *(const LAS bf16x8*)(lds + MX_KS + (32 * kt + r32) * MX_KSTR + (kvh * 64 + ks * 16 + hi * 8) * 2);
                a = __builtin_amdgcn_mfma_f32_32x32x16_bf16(kf, qf[ks], a, 0, 0, 0); }
            s[kt] = a;
        }
        const float sink2 = sinks[wid] * LOG2E;
        float mx = sink2;
        if (t0 >= 128) {
#pragma unroll
            for (int r = 0; r < 16; ++r) { const int k0 = crow(r, hi); if (k0 <= r32) s[0][r] = -1.0e30f; if (k0 > r32) s[4][r] = -1.0e30f; }
        } else {
#pragma unroll
            for (int kt = 0; kt < 5; ++kt)
#pragma unroll
                for (int r = 0; r < 16; ++r) { const int kk = 32 * kt + crow(r, hi); const int diff = (128 + r32) - kk;
                    const bool ok = (diff >= 0) && (diff < 128) && (t0 - 128 + kk >= 0); if (!ok) s[kt][r] = -1.0e30f; }
        }
#pragma unroll
        for (int kt = 0; kt < 5; ++kt)
#pragma unroll
            for (int r = 0; r < 16; ++r) mx = fmaxf(mx, s[kt][r]);
        mx = half_max(mx);
        float lsum = 0.f;
#pragma unroll
        for (int kt = 0; kt < 5; ++kt)
#pragma unroll
            for (int r = 0; r < 16; ++r) { const float e = __builtin_amdgcn_exp2f(s[kt][r] - mx); s[kt][r] = e; lsum += e; }
        lsum = half_sum(lsum); lsum += __builtin_amdgcn_exp2f(sink2 - mx);
        const float linv = 1.0f / lsum;
        f32x16 o[2];
#pragma unroll
        for (int dh = 0; dh < 2; ++dh) {
            f32x16 a = (f32x16){0.f, 0.f, 0.f, 0.f, 0.f, 0.f, 0.f, 0.f, 0.f, 0.f, 0.f, 0.f, 0.f, 0.f, 0.f, 0.f};
            const LAS unsigned char* vrow = lds + MX_VT + (kvh * 64 + 32 * dh + r32) * MX_VSTR;
#pragma unroll
            for (int kt = 0; kt < 5; ++kt)
#pragma unroll
                for (int st = 0; st < 2; ++st) {
                    const int key0 = 32 * kt + 16 * st + 4 * hi;
                    const u32x2 v0 = *(const LAS u32x2*)(vrow + key0 * 2), v1 = *(const LAS u32x2*)(vrow + (key0 + 8) * 2);
                    u32x4 av; av.x = v0.x; av.y = v0.y; av.z = v1.x; av.w = v1.y;
                    u32x4 pv; pv.x = cvt_pk_bf16(s[kt][8 * st + 0], s[kt][8 * st + 1]); pv.y = cvt_pk_bf16(s[kt][8 * st + 2], s[kt][8 * st + 3]);
                    pv.z = cvt_pk_bf16(s[kt][8 * st + 4], s[kt][8 * st + 5]); pv.w = cvt_pk_bf16(s[kt][8 * st + 6], s[kt][8 * st + 7]);
                    a = __builtin_amdgcn_mfma_f32_32x32x16_bf16(__builtin_bit_cast(bf16x8, av), __builtin_bit_cast(bf16x8, pv), a, 0, 0, 0);
                    if (st) __builtin_amdgcn_sched_barrier(0);
                }
            o[dh] = a;
        }
        float q2 = 0.f;
#pragma unroll
        for (int dh = 0; dh < 2; ++dh)
#pragma unroll
            for (int r = 0; r < 16; ++r) { const float v = o[dh][r] * linv; o[dh][r] = v; q2 += v * v; }
        q2 = half_sum(q2);
        if (hi == 0) ((LAS float*)(lds + MX_XA))[wid * 32 + r32] = q2;
        MX_BAR();
        {
            float tot = 0.f;
#pragma unroll
            for (int w = 0; w < 8; ++w) tot += ((LAS float*)(lds + MX_XA))[w * 32 + r32];
            const float rA = rsqrtf(tot * (1.0f / 512.0f) + EPS);
            bf16_t* orow = mrg + drow(row0 + r32) + wid * 64;
#pragma unroll
            for (int dh = 0; dh < 2; ++dh)
#pragma unroll
                for (int pq = 0; pq < 2; ++pq) { u32x2 w2[2];
#pragma unroll
                    for (int h2 = 0; h2 < 2; ++h2) { const int rq = 2 * pq + h2, d0 = 32 * dh + 8 * rq + 4 * hi; const f32x4 g = *(const LAS f32x4*)(lds + MX_TAB + (wid * 64 + d0) * 4);
                        w2[h2].x = cvt_pk_bf16(o[dh][4 * rq + 0] * rA * g.x, o[dh][4 * rq + 1] * rA * g.y); w2[h2].y = cvt_pk_bf16(o[dh][4 * rq + 2] * rA * g.z, o[dh][4 * rq + 3] * rA * g.w); }
                    *(u32x4*)(orow + 32 * dh + 16 * pq + 8 * hi) = pair16(w2[0], w2[1]); }
        }
        bf16x8 wf[2][8];
#pragma unroll
        for (int e = 0; e < 2; ++e)
#pragma unroll
            for (int ks = 0; ks < 8; ++ks) wf[e][ks] = *(const bf16x8*)(pwT + ((size_t)((wid >> 1) * 128 + 32 * (2 * (wid & 1) + e) + r32)) * 128 + hi * 8 + ks * 16);
        {
            const int cp = tid & 255, ts = 16 * (tid >> 8), gsel = __builtin_amdgcn_readfirstlane(cp >> 6);
            const LAS unsigned* U = (const LAS unsigned*)(lds + MX_US) + cp;
            if (gsel == 0) pool_w<2>(U, lds + MX_PL, t0, ts, cp); else if (gsel == 1) pool_w<4>(U, lds + MX_PL, t0, ts, cp);
            else if (gsel == 2) pool_w<8>(U, lds + MX_PL, t0, ts, cp); else pool_w<16>(U, lds + MX_PL, t0, ts, cp);
        }
        MX_BAR();
        {
            const int g = wid >> 1, nh = wid & 1;
            f32x16 acc2[2];
#pragma unroll
            for (int e = 0; e < 2; ++e) {
                f32x16 a = (f32x16){0.f, 0.f, 0.f, 0.f, 0.f, 0.f, 0.f, 0.f, 0.f, 0.f, 0.f, 0.f, 0.f, 0.f, 0.f, 0.f};
#pragma unroll
                for (int ks = 0; ks < 8; ++ks) { const bf16x8 af = wf[e][ks];
                    const bf16x8 bfr = *(const LAS bf16x8*)(lds + MX_PL + r32 * MX_PSTR + (g * 128 + ks * 16 + hi * 8) * 2);
                    a = __builtin_amdgcn_mfma_f32_32x32x16_bf16(af, bfr, a, 0, 0, 0); }
                acc2[e] = a;
            }
            float q3 = 0.f;
#pragma unroll
            for (int e = 0; e < 2; ++e)
#pragma unroll
                for (int rq = 0; rq < 4; ++rq) { const int ch = g * 128 + 32 * (2 * nh + e) + 8 * rq + 4 * hi; const f32x4 sc = *(const LAS f32x4*)(lds + MX_TAB + (1024 + ch) * 4);
#pragma unroll
                    for (int j = 0; j < 4; ++j) { const float v = acc2[e][4 * rq + j] * sc[j]; acc2[e][4 * rq + j] = v; q3 += v * v; } }
            q3 = half_sum(q3);
            if (hi == 0) ((LAS float*)(lds + MX_XB))[wid * 32 + r32] = q3;
            MX_BAR();
            float tot = 0.f;
#pragma unroll
            for (int w = 0; w < 8; ++w) tot += ((LAS float*)(lds + MX_XB))[w * 32 + r32];
            const float rB = rsqrtf(tot * (1.0f / 512.0f) + EPS);
            bf16_t* orow = mrg + drow(row0 + r32) + 512;
#pragma unroll
            for (int e = 0; e < 2; ++e)
#pragma unroll
                for (int pq = 0; pq < 2; ++pq) { u32x2 w2[2];
#pragma unroll
                    for (int h2 = 0; h2 < 2; ++h2) { const int rq = 2 * pq + h2, ch = g * 128 + 32 * (2 * nh + e) + 8 * rq + 4 * hi; const f32x4 gg = *(const LAS f32x4*)(lds + MX_TAB + (512 + ch) * 4);
                        w2[h2].x = cvt_pk_bf16(acc2[e][4 * rq + 0] * rB * gg.x, acc2[e][4 * rq + 1] * rB * gg.y); w2[h2].y = cvt_pk_bf16(acc2[e][4 * rq + 2] * rB * gg.z, acc2[e][4 * rq + 3] * rB * gg.w); }
                    *(u32x4*)(orow + g * 128 + 32 * (2 * nh + e) + 16 * pq + 8 * hi) = pair16(w2[0], w2[1]); }
        }
    }
}

#define XB_TMO      128
#define XB_XCNT(j)  (256  + 64 * (j))
#define XB_XSUB(j)  (1280 + 64 * (j))
#define XB_XGEN(j)  (2304 + 64 * (j))
#define XB_TOP      3328
#define XB_TOPGEN   3392
#define XCD_BAR_WORDS 3456
#define XB_SPIN_CAP (1u << 18)

__device__ __forceinline__ unsigned xb_ld(unsigned* p)              { return __hip_atomic_load(p, __ATOMIC_RELAXED, __HIP_MEMORY_SCOPE_AGENT); }
__device__ __forceinline__ unsigned xb_add(unsigned* p, unsigned v) { return __hip_atomic_fetch_add(p, v, __ATOMIC_RELAXED, __HIP_MEMORY_SCOPE_AGENT); }
__device__ __forceinline__ unsigned xb_xcc_id() { return (unsigned)__builtin_amdgcn_s_getreg((3 << 11) | 20) & 0xFu; }
#define XB_SPIN(cond, bar) do { unsigned _sp = 0; while (cond) { __builtin_amdgcn_s_sleep(1); \
    if ((++_sp & 255u) == 0u) { if (xb_ld(&(bar)[XB_TMO])) break; if (_sp > XB_SPIN_CAP) { atomicAdd(&(bar)[XB_TMO], 1u); break; } } } } while (0)

struct XcdBarrier {
    unsigned* bar; unsigned x;
    volatile LAS unsigned* st;
};

__device__ __forceinline__ XcdBarrier xcd_barrier_post(unsigned* bar, volatile LAS unsigned* st) {
    XcdBarrier b; b.bar = bar; b.x = xb_xcc_id(); b.st = st;
    if (threadIdx.x == 0) (void)xb_add(&bar[XB_XCNT(b.x)], 1u);
    return b;
}
__device__ __forceinline__ void xcd_barrier_complete(unsigned* bar, unsigned x, unsigned& nloc, unsigned& nx) {
    const unsigned G = gridDim.x * gridDim.y * gridDim.z;
    unsigned sum, cnt, mine, sp = 0u;
    for (;;) {
        sum = 0u; cnt = 0u; mine = 0u;
#pragma unroll
        for (unsigned j = 0; j < 16; ++j) { const unsigned c = xb_ld(&bar[XB_XCNT(j)]); sum += c; cnt += (c > 0u) ? 1u : 0u; mine = (j == x) ? c : mine; }
        if (sum == G) break;
        __builtin_amdgcn_s_sleep(1);
        if ((++sp & 255u) == 0u) { if (xb_ld(&bar[XB_TMO])) break; if (sp > XB_SPIN_CAP) { atomicAdd(&bar[XB_TMO], 1u); break; } }
    }
    nloc = mine > 0u ? mine : 1u; nx = cnt > 0u ? cnt : 1u;
}

__device__ __forceinline__ void xcd_barrier(const XcdBarrier& b) {
    asm volatile("s_waitcnt vmcnt(0)" ::: "memory");
    __syncthreads();
    if (threadIdx.x == 0) {
        unsigned* bar = b.bar;
        __builtin_amdgcn_s_waitcnt(0);
        unsigned nloc = b.st[0], nx = b.st[1];
        if (nloc == 0u) { xcd_barrier_complete(bar, b.x, nloc, nx); b.st[0] = nloc; b.st[1] = nx; }
        const unsigned old = xb_add(&bar[XB_XSUB(b.x)], 1u);
        const unsigned gen = old / nloc;
        if (old + 1u == (gen + 1u) * nloc) {
            __builtin_amdgcn_fence(__ATOMIC_RELEASE, "agent");
            asm volatile("s_waitcnt vmcnt(0)" ::: "memory");
            const unsigned og = xb_add(&bar[XB_TOP], 1u);
            const unsigned tg = og / nx;
            if (og + 1u == (tg + 1u) * nx) xb_add(&bar[XB_TOPGEN], 1u);
            else XB_SPIN(xb_ld(&bar[XB_TOPGEN]) == tg, bar);
            __builtin_amdgcn_fence(__ATOMIC_ACQUIRE, "agent");
            xb_add(&bar[XB_XGEN(b.x)], 1u);
            asm volatile("s_waitcnt vmcnt(0)" ::: "memory");
        } else {
            XB_SPIN(xb_ld(&bar[XB_XGEN(b.x)]) == gen, bar);
            __builtin_amdgcn_fence(__ATOMIC_ACQUIRE, "agent");
            asm volatile("s_waitcnt vmcnt(0)" ::: "memory");
        }
    }
    __syncthreads();
}

#define XL_SUB(j)   (3456 + 64 * (j))
#define XL_GEN(j)   (3456 + 1024 + 64 * (j))
__device__ __forceinline__ void xcd_local_barrier(unsigned* bar, unsigned x, unsigned nloc) {
    asm volatile("s_waitcnt vmcnt(0)" ::: "memory");
    __syncthreads();
    if (threadIdx.x == 0) {
        __builtin_amdgcn_s_waitcnt(0);
        const unsigned old = xb_add(&bar[XL_SUB(x)], 1u);
        const unsigned gen = old / nloc;
        if (old + 1u == (gen + 1u) * nloc) xb_add(&bar[XL_GEN(x)], 1u);
        else XB_SPIN(xb_ld(&bar[XL_GEN(x)]) == gen, bar);
        __builtin_amdgcn_fence(__ATOMIC_ACQUIRE, "agent");
        asm volatile("s_waitcnt vmcnt(0)" ::: "memory");
    }
    __syncthreads();
}

constexpr int N_HEAD = 1, N_SUB = 9, N_PHASES = N_HEAD + 2 * N_SUB + 1;
__global__ void __launch_bounds__(512) hymba_fwd(Params p) {
    extern __shared__ __attribute__((aligned(16))) unsigned char lds_raw[];
    LAS unsigned char* lds = (LAS unsigned char*)lds_raw;
    unsigned char* ws = p.ws;
    bf16_t* XB = (bf16_t*)(ws + OFF_XB); bf16_t* ACT = (bf16_t*)(ws + OFF_ACT); bf16_t* PROJ = (bf16_t*)(ws + OFF_PROJ); bf16_t* MRG = (bf16_t*)((unsigned char*)p.out + DO_MRG); bf16_t* PB = (bf16_t*)((unsigned char*)p.out + DO_P);
    float* SSQ = (float*)(ws + OFF_SSQ);
    const size_t BIG = (size_t)256 * 1024;
    volatile LAS unsigned* MISCW = (volatile LAS unsigned*)(lds + LDS_BARST);
    if (threadIdx.x < 8) MISCW[threadIdx.x] = (threadIdx.x == 2) ? blockIdx.x : 0u;
    __syncthreads();
    if (threadIdx.x == 0) { const unsigned x_ = xb_xcc_id(); MISCW[5] = x_; MISCW[4] = xb_add(&((unsigned*)(ws + OFF_CTL))[XB_XCNT(x_)], 1u); }
    if (p.ph_lo <= 0 && 0 < p.ph_hi) { for (int rep = 0; rep <= PROBE_PRO; ++rep) { if (rep) GSYNC(); prologue(p, lds); __syncthreads(); } }
    bool synced = false;
    if (p.ph_lo == 0 && p.ph_hi > 1) {
        GSYNC(); synced = true;
        if (threadIdx.x == 0) {
            unsigned* bar = (unsigned*)(ws + OFF_CTL); bool ok = (gridDim.x == 256);
            for (unsigned j = 0; j < 16; ++j) { const unsigned c = xb_ld(&bar[XB_XCNT(j)]); ok = ok && (c == (j < 8 ? 32u : 0u)); }
            if (ok && MISCW[4] < 32u && MISCW[5] < 8u) { MISCW[2] = MISCW[4] * 8u + MISCW[5]; MISCW[3] = 1u; }
        }
        __syncthreads();
    }
    const int ph_a = p.ph_lo > N_HEAD ? p.ph_lo : N_HEAD, ph_b = p.ph_hi < N_PHASES - 1 ? p.ph_hi : N_PHASES - 1;
    for (int ph = ph_a; ph < ph_b; ++ph) {
        const int l = (ph - N_HEAD) / N_SUB, sp = (ph - N_HEAD) % N_SUB;
        for (int rep = 0; rep <= ((PROBE_MASK >> sp) & 1); ++rep) {
        if (rep || (ph > p.ph_lo && !(synced && ph == N_HEAD))) SEAM(!rep && !(l == 0 && sp == 0) && sp != 3 && !(sp == 4 && l == 0));
        unsigned char* wl = ws + OFF_W + (size_t)l * WL_BYTES;
        if (sp == 0 || sp == 7) {
            Gemm g{XB, (const bf16_t*)(wl + (sp == 0 ? WO_GU1 : WO_GU2)), 1024, 1024, 1024, 128, 22, 1 << 30, BIG, 0, 0, BIG, 0, 0};
            EpiGateUp E{SSQ, ACT};
            gemm_phase<EpiGateUp>(lds, g, E);
        } else if (sp == 1 || sp == 8 || sp == 4 || sp == 6) {
            Gemm g;
            if (sp == 1 || sp == 8) g = Gemm{ACT, (const bf16_t*)(wl + (sp == 1 ? WO_D1 : WO_D2)), FF, FF, FF, 128, 4, 1 << 30, (size_t)256 * FF, 0, 0, (size_t)256 * FF, 0, 0};
            else if (sp == 4) g = Gemm{MRG, (const bf16_t*)(wl + WO_OUT), 1024, 1024, 1024, 128, 4, 1 << 30, BIG, (size_t)1 << 23, 0, BIG, 0, 0, 16};
            else g = Gemm{PB, (const bf16_t*)(ws + OFF_WVO) + (size_t)l * 4 * SLOT, 1024, 1024, 1024, 128, 4, 32, BIG, (size_t)1 << 23, 0, BIG, SLOT, 0, 16};
            EpiResid E{XB, SSQ, (sp == 1 || sp == 8) ? 0.5f : 1.0f};
            gemm_phase<EpiResid>(lds, g, E);
        } else if (sp == 2) {
            Gemm g{XB, (const bf16_t*)(wl + WO_IN), 1024, 1024, 1024, 128, 5, 1 << 30, BIG, 0, 0, BIG, 0, 0};
            EpiWin E{SSQ, (const float*)(ws + OFF_COS), (const float*)(ws + OFF_SIN), PROJ, (bf16_t*)(ws + OFF_QF), (bf16_t*)(ws + OFF_VTG)};
            gemm_phase<EpiWin>(lds, g, E);
        } else if (sp == 3) {
            mixer_phase(lds, PROJ, (const bf16_t*)(ws + OFF_QF), (const bf16_t*)(ws + OFF_VTG), MRG, (const bf16_t*)(wl + WO_PW), p.in[9] + l * 8, p.in[12] + l * 512, p.in[13] + l * 512, p.in[11] + l * 512);
        } else if (sp == 5) {
            Gemm g{XB, (const bf16_t*)(ws + OFF_WQK) + (size_t)l * 4 * SLOT, 1024, 1024, 1024, 128, 4, 32, BIG, 32 * BIG, 0, BIG, SLOT, 0};
            EpiSoftmax E{SSQ, PB, 1024};
            gemm_phase<EpiSoftmax>(lds, g, E);
        }
        const int nbf = (l == 0 && rep == 0) ? (sp == 2 ? 1 : sp == 3 ? 16 : 0) : 0;
        for (int i = 0; i < nbf; ++i) {
            Gemm g; EpiBf16 E;
            if (sp == 2) {
                g = Gemm{(const bf16_t*)(ws + OFF_MEMN), (const bf16_t*)(ws + OFF_WKV), 1024, 1024, 1024, 8, 8, 4, BIG, 4 * BIG, 0, BIG, 2 * SLOT, 128};
                E = EpiBf16{(bf16_t*)(ws + OFF_KVH), 0, 0, 256, 1, 1.0f};
            } else {
                const int lh = i & 7, l2 = lh >> 2, h = lh & 3;
                if (i < 8) {
                    g = Gemm{(const bf16_t*)(ws + OFF_KVH) + (size_t)(lh * 4) * 65536, (const bf16_t*)(ws + OFF_WQN) + (size_t)lh * 262144, 256, 256, 256, 4, 4, 1 << 30, 65536, 0, 0, 65536, 0, 16 * i};
                    E = EpiBf16{(bf16_t*)(ws + OFF_WQK) + (size_t)l2 * 4 * SLOT + (size_t)h * 256 * 1024, SLOT, 256, 1024, 0, QSCALE_X};
                } else {
                    g = Gemm{(const bf16_t*)(ws + OFF_WOT) + (size_t)lh * 262144, (const bf16_t*)(ws + OFF_KVH) + (size_t)(32 + lh * 4) * 65536, 256, 256, 256, 4, 4, 1 << 30, 65536, 0, 0, 65536, 0, 16 * i};
                    E = EpiBf16{(bf16_t*)(ws + OFF_WVO) + (size_t)l2 * 4 * SLOT + (size_t)h * 256, BIG, SLOT, 1024, 0, 1.0f};
                }
            }
            gemm_phase<EpiBf16>(lds, g, E);
        }
        }
    }
    if (p.ph_lo <= N_PHASES - 1 && N_PHASES - 1 < p.ph_hi) {
        if (N_PHASES - 1 > p.ph_lo) SEAM(true);
        int tid_ = threadIdx.x; asm volatile("" : "+v"(tid_));
        const int vcu = (int)MISCW[2]; const int lane = tid_ & 63, gw = vcu * 8 + (tid_ >> 6), NGW = gridDim.x * 8;
        for (int row0 = gw; row0 < MT; row0 += NGW) {
            const int k_ = row0 / NGW;
            const int row = (gridDim.x == 256) ? 4096 * (vcu & 7) + 128 * (vcu >> 3) + 16 * (tid_ >> 6) + k_ : row0;
            const float r = row_rs(SSQ, row); const u32x2* xr = (const u32x2*)(XB + (size_t)row * DM) + lane; f32x4* orow = (f32x4*)(p.out + (size_t)row * DM) + lane; const f32x4* gr = (const f32x4*)p.in[24] + lane;
#pragma unroll
            for (int j = 0; j < 4; ++j) { const u32x2 v = xr[64 * j]; const f32x4 g = gr[64 * j]; orow[64 * j] = (f32x4){bf_lo(v.x) * r * g.x, bf_hi(v.x) * r * g.y, bf_lo(v.y) * r * g.z, bf_hi(v.y) * r * g.w}; }
        }
    }
}

extern "C" void kernel_launch(void* const* d_in, const int* in_sizes, int n_in, void* d_out, int out_size, void* d_ws, size_t ws_size, hipStream_t stream) {
    static int grid = 0;
    if (grid == 0) {
        if (n_in != 25 || out_size != MT * DM || ws_size < WS_END) { fprintf(stderr, "kernel_launch: unexpected shapes (n_in %d out %d ws %zu need %zu)\n", n_in, out_size, ws_size, (size_t)WS_END); grid = -1; return; }
        int dev = 0, cus = 0, per_cu = 0;
        hipGetDevice(&dev); hipDeviceGetAttribute(&cus, hipDeviceAttributeMultiprocessorCount, dev);
        if (hipFuncSetAttribute((const void*)hymba_fwd, hipFuncAttributeMaxDynamicSharedMemorySize, LDS_BYTES) != hipSuccess) { fprintf(stderr, "kernel_launch: hipFuncSetAttribute failed\n"); grid = -1; return; }
        if (hipOccupancyMaxActiveBlocksPerMultiprocessor(&per_cu, (const void*)hymba_fwd, 512, LDS_BYTES) != hipSuccess || per_cu < 1) { fprintf(stderr, "kernel_launch: occupancy query gave %d\n", per_cu); per_cu = 1; }
        (void)hipGetLastError();
        grid = cus;
    }
    if (grid < 0) return;
    Params p{};
    for (int i = 0; i < 25; ++i) p.in[i] = (const float*)d_in[i];
    p.out = (float*)d_out; p.ws = (unsigned char*)d_ws;
#if MK_ONE_LAUNCH
    p.ph_lo = 0; p.ph_hi = N_PHASES;
    if (hipMemsetAsync((char*)d_ws + OFF_CTL, 0, CTL_BYTES, stream) != hipSuccess) { fprintf(stderr, "kernel_launch: memset of the barrier words failed\n"); return; }
    void* args[] = {&p};
    hipError_t e = hipLaunchCooperativeKernel((const void*)hymba_fwd, dim3(grid), dim3(512), args, LDS_BYTES, stream);
    if (e != hipSuccess) fprintf(stderr, "cooperative launch failed: %s (grid %d)\n", hipGetErrorString(e), grid);
#else
    for (int ph = 0; ph < N_PHASES; ++ph) { p.ph_lo = ph; p.ph_hi = ph + 1; hipLaunchKernelGGL(hymba_fwd, dim3(grid), dim3(512), LDS_BYTES, stream, p); }
#endif
}
```

```cpp
#include <hip/hip_runtime.h>
#include <hip/hip_cooperative_groups.h>
#include <cstdio>
#include <cstdint>
namespace cg = cooperative_groups;

#ifndef MK_ONE_LAUNCH
#define MK_ONE_LAUNCH 1
#endif
#ifndef PROBE_MASK
#define PROBE_MASK 0
#endif
#ifndef PROBE_PRO
#define PROBE_PRO 0
#endif
#ifndef PROBE_NSYNC
#define PROBE_NSYNC 1
#endif
#define SEAM(local_ok_) do { if ((local_ok_) && MISCW[3]) { unsigned char* wq2_ = p.ws; asm volatile("" : "+v"(wq2_)); xcd_local_barrier((unsigned*)(wq2_ + OFF_CTL), MISCW[5], 32u); } else GSYNC(); } while (0)
#define GSYNC() do { for (int s_ = 0; s_ < PROBE_NSYNC; ++s_) { if (p.ph_hi > 4096) cg::this_grid().sync(); else { XcdBarrier gb_; { unsigned char* wq_ = p.ws; asm volatile("" : "+v"(wq_)); gb_.bar = (unsigned*)(wq_ + OFF_CTL); } gb_.x = xb_xcc_id(); gb_.st = (volatile LAS unsigned*)(lds + LDS_BARST); xcd_barrier(gb_); } } } while (0)

#define LAS __attribute__((address_space(3)))
typedef unsigned short bf16_t;
typedef short bf16x8 __attribute__((ext_vector_type(8)));
typedef float f32x4 __attribute__((ext_vector_type(4)));
typedef float f32x16 __attribute__((ext_vector_type(16)));
typedef unsigned u32x4 __attribute__((ext_vector_type(4)));
typedef unsigned u32x2 __attribute__((ext_vector_type(2)));

constexpr int MT = 32768;
constexpr int SEQ = 8192;
constexpr int DM = 1024;
constexpr int FF = 2816;
constexpr int INW = 1280;
constexpr float EPS = 1e-6f;
constexpr float LOG2E = 1.4426950408889634f;
constexpr float QSCALE_SWA = 0.125f * LOG2E;
constexpr float QSCALE_X = 0.0625f * LOG2E;

constexpr size_t SLOT = 1024 * 1024;
constexpr size_t WO_GU1 = 0;
constexpr size_t WO_D1 = WO_GU1 + (size_t)5632 * 1024 * 2;
constexpr size_t WO_IN = WO_D1 + (size_t)1024 * 2816 * 2;
constexpr size_t WO_OUT = WO_IN + (size_t)1280 * 1024 * 2;
constexpr size_t WO_GU2 = WO_OUT + SLOT * 2;
constexpr size_t WO_D2 = WO_GU2 + (size_t)5632 * 1024 * 2;
constexpr size_t WO_PW = WO_D2 + (size_t)1024 * 2816 * 2;
constexpr size_t WL_BYTES = WO_PW + 4 * 128 * 128 * 2;
constexpr size_t OFF_W = 0;
constexpr size_t OFF_WQN = OFF_W + 2 * WL_BYTES;
constexpr size_t OFF_WOT = OFF_WQN + 2 * SLOT * 2;
constexpr size_t OFF_MEMN = OFF_WOT + 2 * SLOT * 2;
constexpr size_t OFF_WKV = OFF_MEMN + 2 * SLOT * 2;
constexpr size_t OFF_KVH = OFF_WKV + 4 * SLOT * 2;
constexpr size_t OFF_WQK = OFF_KVH + 64 * 65536 * 2;
constexpr size_t OFF_WVO = OFF_WQK + 8 * SLOT * 2;
constexpr size_t OFF_XB = OFF_WVO + 8 * SLOT * 2;
constexpr size_t OFF_ACT = OFF_XB + (size_t)MT * DM * 2;
constexpr size_t OFF_PROJ = OFF_ACT + (size_t)MT * FF * 2;
constexpr size_t OFF_SSQ = OFF_PROJ + (size_t)MT * INW * 2;
constexpr size_t OFF_QF = OFF_SSQ + (size_t)MT * 16 * 4;
constexpr size_t OFF_VTG = OFF_QF + (size_t)MT * 512 * 2;
constexpr size_t OFF_COS = OFF_VTG + (size_t)4 * 128 * SEQ * 2;
constexpr size_t OFF_SIN = OFF_COS + (size_t)MT * 32 * 4;
constexpr size_t OFF_CTL = OFF_SIN + (size_t)MT * 32 * 4;
constexpr size_t DO_P = 0, DO_MRG = (size_t)8 << 20;
__device__ __forceinline__ size_t drow(size_t r) { return ((r >> 12) << 23) + (r & 4095) * 1024; }
constexpr size_t CTL_BYTES = 32768;
constexpr size_t WS_END = OFF_CTL + CTL_BYTES;

constexpr int LDS_XCH = 131072;
constexpr int LDS_BARST = 131072 + 8192 + 512;
constexpr int LDS_RS = 131072 + 8192 + 1024;
constexpr int LDS_BYTES = LDS_RS + 12 * 1024;

__device__ __forceinline__ unsigned cvt_pk_bf16(float lo, float hi) { unsigned r; asm volatile("v_cvt_pk_bf16_f32 %0, %1, %2" : "=v"(r) : "v"(lo), "v"(hi)); return r; }
__device__ __forceinline__ u32x4 pair16(u32x2 we, u32x2 wo) {
    const auto a = __builtin_amdgcn_permlane32_swap(we.x, wo.x, false, false), b = __builtin_amdgcn_permlane32_swap(we.y, wo.y, false, false);
    u32x4 r; r.x = a[0]; r.y = b[0]; r.z = a[1]; r.w = b[1]; return r;
}
__device__ __forceinline__ float bf_lo(unsigned u) { return __uint_as_float(u << 16); }
__device__ __forceinline__ float bf_hi(unsigned u) { return __uint_as_float(u & 0xffff0000u); }
__device__ __forceinline__ float wave_sum(float v) {
#pragma unroll
    for (int o = 1; o < 64; o <<= 1) v += __shfl_xor(v, o);
    return v;
}
__device__ __forceinline__ float rs_of(f32x4 a) { return rsqrtf(((a.x + a.y) + (a.z + a.w)) * (1.0f / 1024.0f) + EPS); }
__device__ __forceinline__ float row_rs(const float* ssq, int row) {
    return rs_of(*(const f32x4*)(ssq + (size_t)row * 4));
}

constexpr int BM = 256, BK = 64, HALF = 128, HTB = HALF * BK * 2, NXCD = 8, WGM = 8;
__device__ __forceinline__ int lds_byte(int r, int c) { const int st = (r >> 4) * 2 + (c >> 5), rr = r & 15, cc = c & 31, ob = rr * 64 + cc * 2; return st * 1024 + (ob ^ (((ob >> 9) & 1) << 5)); }
__device__ __forceinline__ void stage_rc(int b, int& R, int& C) { const int st = b / 1024, sb = b % 1024, swz = sb ^ (((sb >> 9) & 1) << 5); R = (st >> 1) * 16 + swz / 64; C = (st & 1) * 32 + (swz % 64) / 2; }
__device__ __forceinline__ int perm32(int rho) { const int n = rho >> 4, i = rho & 15; return 8 * (i >> 2) + 4 * n + (i & 3); }

struct Unit { int pm, pn; };
struct Gemm { const bf16_t* A; const bf16_t* Bt; int lda, ldb, K, nM, nN, pm_div; size_t a_pm, a_b, a_pn, b_pn, b_b; int c_shift; int a_div; };
struct StaticOrder {
    int nM, nN, nwg, G, c;
    __device__ void init(int nM_, int nN_, int G_, int c_) { nM = nM_; nN = nN_; nwg = nM * nN; G = G_; c = c_; }
    __device__ bool next(int i, Unit& u) const {
        const long L = (long)i * G + c; if (L >= nwg) return false;
        int wgid = (int)L; { const int q = nwg / NXCD, r = nwg % NXCD, xcd = wgid % NXCD, off = wgid / NXCD; wgid = (xcd < r ? xcd * (q + 1) : r * (q + 1) + (xcd - r) * q) + off; }
        const int nig = WGM * nN, gid = wgid / nig, fm = gid * WGM, gsz = (nM - fm) < WGM ? (nM - fm) : WGM;
        u.pm = fm + ((wgid % nig) % gsz); u.pn = (wgid % nig) / gsz; return true;
    }
};

typedef f32x4 Acc[2][2][4][2];

struct EpiGateUp {
    static constexpr bool PERM = true, XCH = false, RS = true;
    const float* ssq; bf16_t* act;
    __device__ __forceinline__ void operator()(Acc& acc, const Unit& u, int ui, int wr, int wc, int fr, int fq, LAS unsigned char* lds) const {
        const LAS float* rsT = (const LAS float*)(lds + LDS_RS) + ui * 256 + wr * 64 + fr;
        const int row0 = u.pm * BM + wr * 64 + fr, col0 = u.pn * 128 + wc * 32 + 8 * fq;
#pragma unroll
        for (int ai = 0; ai < 2; ++ai)
#pragma unroll
            for (int m = 0; m < 4; ++m) {
                const int row = row0 + ai * HALF + m * 16; const float r = rsT[ai * HALF + m * 16];
                const float c1 = -r * LOG2E, r2 = r * r;
                float o[8];
#pragma unroll
                for (int n = 0; n < 2; ++n) { const f32x4 g = acc[ai][0][m][n], up = acc[ai][1][m][n]; const f32x4 t = g * c1;
                    f32x4 e; e.x = __builtin_amdgcn_exp2f(t.x); e.y = __builtin_amdgcn_exp2f(t.y); e.z = __builtin_amdgcn_exp2f(t.z); e.w = __builtin_amdgcn_exp2f(t.w);
                    const f32x4 d = e + 1.0f; f32x4 rc; rc.x = __builtin_amdgcn_rcpf(d.x); rc.y = __builtin_amdgcn_rcpf(d.y); rc.z = __builtin_amdgcn_rcpf(d.z); rc.w = __builtin_amdgcn_rcpf(d.w);
                    const f32x4 v = (g * up) * (rc * r2);
                    o[n * 4 + 0] = v.x; o[n * 4 + 1] = v.y; o[n * 4 + 2] = v.z; o[n * 4 + 3] = v.w; }
                u32x4 w; w.x = cvt_pk_bf16(o[0], o[1]); w.y = cvt_pk_bf16(o[2], o[3]); w.z = cvt_pk_bf16(o[4], o[5]); w.w = cvt_pk_bf16(o[6], o[7]);
                *(u32x4*)(act + (size_t)row * FF + col0) = w;
            }
    }
};
struct EpiResid {
    static constexpr bool PERM = true, XCH = false, RS = false;
    bf16_t* xb; float* ssq; float alpha;
    __device__ __forceinline__ void operator()(Acc& acc, const Unit& u, int ui, int wr, int wc, int fr, int fq, LAS unsigned char* lds) const {
        LAS float* X = (LAS float*)(lds + LDS_XCH);
        const int row0 = u.pm * BM + wr * 64 + fr, col0 = u.pn * BM + wc * 32 + 8 * fq;
#pragma unroll
        for (int ai = 0; ai < 2; ++ai)
#pragma unroll
            for (int m = 0; m < 4; ++m) {
                const int row = row0 + ai * HALF + m * 16; bf16_t* xr = xb + (size_t)row * DM + col0; float q = 0.f;
                const u32x4 x0 = *(const u32x4*)xr, x1 = *(const u32x4*)(xr + HALF);
#pragma unroll
                for (int bj = 0; bj < 2; ++bj) { const u32x4 xo = bj ? x1 : x0; float v[8];
#pragma unroll
                    for (int n = 0; n < 2; ++n) { const f32x4 a = acc[ai][bj][m][n] * alpha;
                        v[4 * n + 0] = bf_lo(xo[2 * n]) + a.x; v[4 * n + 1] = bf_hi(xo[2 * n]) + a.y; v[4 * n + 2] = bf_lo(xo[2 * n + 1]) + a.z; v[4 * n + 3] = bf_hi(xo[2 * n + 1]) + a.w; }
#pragma unroll
                    for (int j = 0; j < 8; ++j) q += v[j] * v[j];
                    u32x4 w; w.x = cvt_pk_bf16(v[0], v[1]); w.y = cvt_pk_bf16(v[2], v[3]); w.z = cvt_pk_bf16(v[4], v[5]); w.w = cvt_pk_bf16(v[6], v[7]);
                    *(u32x4*)(xr + bj * HALF) = w; }
                q += __shfl_xor(q, 16); q += __shfl_xor(q, 32);
                if (fq == 0) X[(ai * HALF + wr * 64 + m * 16 + fr) * 4 + wc] = q;
            }
        asm volatile("s_waitcnt lgkmcnt(0)" ::: "memory"); __builtin_amdgcn_s_barrier(); asm volatile("" ::: "memory");
        const int t = (wr * 4 + wc) * 64 + fq * 16 + fr;
        if (t < 256) { const f32x4 v = *(const LAS f32x4*)(X + t * 4); ssq[(size_t)(u.pm * BM + t) * 4 + u.pn] = (v.x + v.y) + (v.z + v.w); }
        asm volatile("s_waitcnt lgkmcnt(0)" ::: "memory");
    }
};
struct EpiWin {
    static constexpr bool PERM = true, XCH = false, RS = true;
    const float* ssq; const float* cs; const float* sn; bf16_t* proj; bf16_t* qf; bf16_t* vtg;
    __device__ __forceinline__ void operator()(Acc& acc, const Unit& u, int ui, int wr, int wc, int fr, int fq, LAS unsigned char* lds) const {
        const LAS float* rsT = (const LAS float*)(lds + LDS_RS) + ui * 256 + wr * 64 + fr;
        const int row0 = u.pm * BM + wr * 64 + fr, tile = u.pn;
        const bool rope = (tile < 2) || (tile == 2 && wc < 2);
#pragma unroll
        for (int ai = 0; ai < 2; ++ai)
#pragma unroll
            for (int m = 0; m < 4; ++m) {
                const int row = row0 + ai * HALF + m * 16; float r = rsT[ai * HALF + m * 16];
                bf16_t* prow = proj + (size_t)row * INW;
                float o0[8], o1[8]; int c0, c1;
                if (rope) {
                    if (tile < 2) r *= QSCALE_SWA;
                    const f32x4 ca = *(const f32x4*)(cs + (size_t)row * 32 + 8 * fq), cb = *(const f32x4*)(cs + (size_t)row * 32 + 8 * fq + 4);
                    const f32x4 sa = *(const f32x4*)(sn + (size_t)row * 32 + 8 * fq), sb = *(const f32x4*)(sn + (size_t)row * 32 + 8 * fq + 4);
#pragma unroll
                    for (int n = 0; n < 2; ++n)
#pragma unroll
                        for (int j = 0; j < 4; ++j) { const float x1 = acc[ai][0][m][n][j] * r, x2 = acc[ai][1][m][n][j] * r; const float c = n ? cb[j] : ca[j], s = n ? sb[j] : sa[j];
                            o0[n * 4 + j] = x1 * c - x2 * s; o1[n * 4 + j] = x2 * c + x1 * s; }
                    c0 = (tile < 2 ? tile * 256 : 512) + wc * 64 + 8 * fq; c1 = c0 + 32;
                } else {
#pragma unroll
                    for (int n = 0; n < 2; ++n)
#pragma unroll
                        for (int j = 0; j < 4; ++j) { o0[n * 4 + j] = acc[ai][0][m][n][j] * r; o1[n * 4 + j] = acc[ai][1][m][n][j] * r; }
                    if (tile == 2) { c0 = 640 + 32 * (wc - 2) + 8 * fq; c1 = c0 + 64; }
                    else { c0 = tile * 256 + wc * 32 + 8 * fq; c1 = c0 + 128; }
                }
                u32x4 w0, w1; w0.x = cvt_pk_bf16(o0[0], o0[1]); w0.y = cvt_pk_bf16(o0[2], o0[3]); w0.z = cvt_pk_bf16(o0[4], o0[5]); w0.w = cvt_pk_bf16(o0[6], o0[7]);
                w1.x = cvt_pk_bf16(o1[0], o1[1]); w1.y = cvt_pk_bf16(o1[2], o1[3]); w1.z = cvt_pk_bf16(o1[4], o1[5]); w1.w = cvt_pk_bf16(o1[6], o1[7]);
                if (tile < 2) {
                    bf16_t* qb = qf + ((((size_t)(row >> 5) * 8 + tile * 4 + wc) * 4 + (fq >> 1)) * 2 + (fq & 1)) * 256 + (size_t)(row & 31) * 8;
                    *(u32x4*)qb = w0; *(u32x4*)(qb + 2 * 2 * 256) = w1;
                } else if (tile == 2 && wc >= 2) {
                    bf16_t* vb = vtg + ((size_t)(row >> 13) * 128 + 32 * (wc - 2) + 8 * fq) * SEQ + (row & (SEQ - 1));
#pragma unroll
                    for (int e = 0; e < 4; ++e) { vb[(size_t)(2 * e) * SEQ] = (bf16_t)(w0[e] & 0xffffu); vb[(size_t)(2 * e + 1) * SEQ] = (bf16_t)(w0[e] >> 16);
                        vb[(size_t)(64 + 2 * e) * SEQ] = (bf16_t)(w1[e] & 0xffffu); vb[(size_t)(64 + 2 * e + 1) * SEQ] = (bf16_t)(w1[e] >> 16); }
                } else { *(u32x4*)(prow + c0) = w0; *(u32x4*)(prow + c1) = w1; }
            }
    }
};
struct EpiBf16 {
    static constexpr bool PERM = true, XCH = false, RS = false;
    bf16_t* out; size_t tb_pm, tb_pn; int ldc, mode; float scale;
    __device__ __forceinline__ void operator()(Acc& acc, const Unit& u, int ui, int wr, int wc, int fr, int fq, LAS unsigned char*) const {
        size_t tb = (size_t)u.pm * tb_pm + (size_t)u.pn * tb_pn;
        if (mode) tb = (size_t)((u.pn >> 2) * 32 + ((u.pm >> 2) * 4 + (u.pn & 3)) * 4 + (u.pm & 3)) * 65536;
        bf16_t* o = out + tb + (size_t)(wr * 64 + fr) * ldc + wc * 32 + 8 * fq;
#pragma unroll
        for (int ai = 0; ai < 2; ++ai)
#pragma unroll
            for (int m = 0; m < 4; ++m) {
#pragma unroll
                for (int bj = 0; bj < 2; ++bj) { const f32x4 v0 = acc[ai][bj][m][0] * scale, v1 = acc[ai][bj][m][1] * scale;
                    u32x4 w; w.x = cvt_pk_bf16(v0.x, v0.y); w.y = cvt_pk_bf16(v0.z, v0.w); w.z = cvt_pk_bf16(v1.x, v1.y); w.w = cvt_pk_bf16(v1.z, v1.w);
                    *(u32x4*)(o + (size_t)(ai * HALF + m * 16) * ldc + bj * HALF) = w; }
            }
    }
};
struct EpiSoftmax {
    static constexpr bool PERM = true, XCH = true, RS = true;
    const float* ssq; bf16_t* out; int ldc;
    __device__ __forceinline__ void operator()(Acc& acc, const Unit& u, int ui, int wr, int wc, int fr, int fq, LAS unsigned char* lds) const {
        const LAS float* rsT = (const LAS float*)(lds + LDS_RS) + ui * 256 + wr * 64 + fr;
        typedef float f32x2v __attribute__((ext_vector_type(2)));
        LAS f32x2v* X = (LAS f32x2v*)(lds + LDS_XCH);
        float mw[2][4];
#pragma unroll
        for (int ai = 0; ai < 2; ++ai)
#pragma unroll
            for (int m = 0; m < 4; ++m) {
                float mx = -3.0e38f; const float r = rsT[ai * HALF + m * 16];
#pragma unroll
                for (int bj = 0; bj < 2; ++bj)
#pragma unroll
                    for (int n = 0; n < 2; ++n) { const f32x4 v = acc[ai][bj][m][n] * r; acc[ai][bj][m][n] = v; mx = fmaxf(mx, fmaxf(fmaxf(v.x, v.y), fmaxf(v.z, v.w))); }
                mx = fmaxf(mx, __shfl_xor(mx, 16)); mx = fmaxf(mx, __shfl_xor(mx, 32));
                float s = 0.f;
#pragma unroll
                for (int bj = 0; bj < 2; ++bj)
#pragma unroll
                    for (int n = 0; n < 2; ++n) { f32x4 v = acc[ai][bj][m][n];
                        v.x = __builtin_amdgcn_exp2f(v.x - mx); v.y = __builtin_amdgcn_exp2f(v.y - mx); v.z = __builtin_amdgcn_exp2f(v.z - mx); v.w = __builtin_amdgcn_exp2f(v.w - mx);
                        s += (v.x + v.y) + (v.z + v.w); acc[ai][bj][m][n] = v; }
                s += __shfl_xor(s, 16); s += __shfl_xor(s, 32);
                mw[ai][m] = mx;
                if (fq == 0) X[(ai * HALF + wr * 64 + m * 16 + fr) * 4 + wc] = (f32x2v){mx, s};
            }
        asm volatile("s_waitcnt lgkmcnt(0)" ::: "memory"); __builtin_amdgcn_s_barrier(); asm volatile("" ::: "memory");
        const int row0 = u.pm * BM + wr * 64 + fr, col0 = u.pn * BM + wc * 32 + 8 * fq;
#pragma unroll
        for (int ai = 0; ai < 2; ++ai)
#pragma unroll
            for (int m = 0; m < 4; ++m) {
                const int rl = ai * HALF + wr * 64 + m * 16 + fr;
                const f32x2v a = X[rl * 4 + 0], b = X[rl * 4 + 1], c = X[rl * 4 + 2], d = X[rl * 4 + 3];
                const float M = fmaxf(fmaxf(a.x, b.x), fmaxf(c.x, d.x));
                const float L = (a.y * __builtin_amdgcn_exp2f(a.x - M) + b.y * __builtin_amdgcn_exp2f(b.x - M)) + (c.y * __builtin_amdgcn_exp2f(c.x - M) + d.y * __builtin_amdgcn_exp2f(d.x - M));
                const float f = __builtin_amdgcn_exp2f(mw[ai][m] - M) / L;
                const int row = row0 + ai * HALF + m * 16;
#pragma unroll
                for (int bj = 0; bj < 2; ++bj) { const f32x4 v0 = acc[ai][bj][m][0] * f, v1 = acc[ai][bj][m][1] * f;
                    u32x4 w; w.x = cvt_pk_bf16(v0.x, v0.y); w.y = cvt_pk_bf16(v0.z, v0.w); w.z = cvt_pk_bf16(v1.x, v1.y); w.w = cvt_pk_bf16(v1.z, v1.w);
                    *(u32x4*)(out + drow((size_t)row) + col0 + bj * HALF) = w; }
            }
        asm volatile("s_waitcnt lgkmcnt(0)" ::: "memory");
    }
};

template <class Epi>
__device__ __forceinline__ void gemm_phase(LAS unsigned char* lds, const Gemm g, const Epi& E) {
    constexpr bool ALIGN_EPI = true;
    int tid_ = threadIdx.x; asm volatile("" : "+v"(tid_));
    const int tid = tid_, wid = __builtin_amdgcn_readfirstlane(tid >> 6), lane = tid & 63, wr = wid >> 2, wc = wid & 3, fr = lane & 15, fq = lane >> 4;
    const int nt = g.K / BK;
    const unsigned vcu = ((volatile LAS unsigned*)(lds + LDS_BARST))[2];
    StaticOrder S; S.init(g.nM, g.nN, (int)gridDim.x, (int)((vcu + gridDim.x - (unsigned)g.c_shift % gridDim.x) % gridDim.x));
    unsigned voffA[2], voffB[2];
#pragma unroll
    for (int i = 0; i < 2; ++i) { int R, C; stage_rc(tid * 16 + i * 8192, R, C); const int Rb = Epi::PERM ? ((R & ~31) + perm32(R & 31)) : R;
        voffA[i] = (unsigned)(R * g.lda + C) * 2u; voffB[i] = (unsigned)(Rb * g.ldb + C) * 2u; }
    const size_t kstep = (size_t)(BK * 2);
    const size_t hstepA = (size_t)HALF * g.lda * 2, hstepB = (size_t)HALF * g.ldb * 2;
    const unsigned ldsw = (unsigned)wid * 1024u;
    const int aoff = lds_byte(wr * 64 + fr, fq * 8), boff = lds_byte(wc * 32 + fr, fq * 8);
#define G_ABASE(u) ((const char*)(g.A + (size_t)((u).pm % (g.a_div ? g.a_div : g.pm_div)) * g.a_pm + (size_t)((u).pm / (g.a_div ? g.a_div : g.pm_div)) * g.a_b + (size_t)(u).pn * g.a_pn))
#define G_BBASE(u) ((const char*)(g.Bt + (size_t)(u).pn * g.b_pn + (size_t)((u).pm / g.pm_div) * g.b_b))
#define PG8_SA(b, h) (((b) * 2 + (h)) * HTB)
#define PG8_SB(b, h) ((4 + (b) * 2 + (h)) * HTB)
#define PG8_STAGE(bufoff, gbase, voff) do { _Pragma("unroll") for (int _i = 0; _i < 2; ++_i) \
        __builtin_amdgcn_global_load_lds((const unsigned*)((const char*)(gbase) + (voff)[_i]), (LAS unsigned*)(lds + (bufoff) + ldsw + _i * 8192), 16, 0, 0); } while (0)
#define PG8_LDA(dst, b, h) do { _Pragma("unroll") for (int m = 0; m < 4; ++m) _Pragma("unroll") for (int k = 0; k < 2; ++k) dst[m][k] = *(const LAS bf16x8*)(lds + PG8_SA(b, h) + aoff + m * 2048 + k * 1024); } while (0)
#define PG8_LDB(dst, b, h) do { _Pragma("unroll") for (int n = 0; n < 2; ++n) _Pragma("unroll") for (int k = 0; k < 2; ++k) dst[n][k] = *(const LAS bf16x8*)(lds + PG8_SB(b, h) + boff + n * 2048 + k * 1024); } while (0)
#define PG8_MMA(ai, bj, At, Bt) do { __builtin_amdgcn_s_setprio(1); _Pragma("unroll") for (int m = 0; m < 4; ++m) _Pragma("unroll") for (int n = 0; n < 2; ++n) _Pragma("unroll") for (int k = 0; k < 2; ++k) \
        acc[ai][bj][m][n] = __builtin_amdgcn_mfma_f32_16x16x32_bf16(Bt[n][k], At[m][k], acc[ai][bj][m][n], 0, 0, 0); __builtin_amdgcn_s_setprio(0); } while (0)
#define PG8_WAIT_V(n) asm volatile("s_waitcnt vmcnt(" #n ")" ::: "memory")
#define PG8_WAIT_L(n) asm volatile("s_waitcnt lgkmcnt(" #n ")" ::: "memory")
#define PG8_BAR __builtin_amdgcn_s_barrier()
#define PG8_SCHED __builtin_amdgcn_sched_barrier(0)
    Unit cur, nxt; int ui = 0;
    if (!S.next(0, cur)) return;
    Acc acc;
#pragma unroll
    for (int a = 0; a < 2; ++a)
#pragma unroll
        for (int b = 0; b < 2; ++b)
#pragma unroll
            for (int m = 0; m < 4; ++m)
#pragma unroll
                for (int n = 0; n < 2; ++n) acc[a][b][m][n] = (f32x4){0.f, 0.f, 0.f, 0.f};
    bf16x8 At[4][2], B0[2][2], B1[2][2];
    const char* cA = G_ABASE(cur); const char* cB = G_BBASE(cur);
    PG8_STAGE(PG8_SB(0, 0), cB, voffB); PG8_STAGE(PG8_SB(0, 1), cB + hstepB, voffB); PG8_STAGE(PG8_SA(0, 0), cA, voffA); PG8_STAGE(PG8_SA(0, 1), cA + hstepA, voffA);
    if constexpr (Epi::RS) {
        f32x4 pv[6]; bool ok[6];
#pragma unroll
        for (int j = 0; j < 6; ++j) { Unit tu; ok[j] = S.next((tid >> 8) + 2 * j, tu); pv[j] = (f32x4){0.f, 0.f, 0.f, 0.f}; if (ok[j]) pv[j] = *(const f32x4*)(E.ssq + (size_t)(tu.pm * BM + (tid & 255)) * 4); }
#pragma unroll
        for (int j = 0; j < 6; ++j) if (ok[j]) ((LAS float*)(lds + LDS_RS))[((tid >> 8) + 2 * j) * 256 + (tid & 255)] = rs_of(pv[j]);
        asm volatile("s_waitcnt lgkmcnt(0)" ::: "memory"); __builtin_amdgcn_s_barrier(); asm volatile("" ::: "memory");
    }
    if (wr == 1) PG8_BAR;
    PG8_WAIT_V(2); PG8_BAR;
    PG8_STAGE(PG8_SB(1, 0), cB + kstep, voffB); PG8_STAGE(PG8_SA(1, 0), cA + kstep, voffA); PG8_STAGE(PG8_SB(1, 1), cB + hstepB + kstep, voffB);
    PG8_WAIT_V(6); PG8_BAR;
    for (;;) {
        const bool has_next = S.next(ui + 1, nxt);
        const char* nA = has_next ? G_ABASE(nxt) : cA; const char* nB = has_next ? G_BBASE(nxt) : cB;
        for (int t = 0; t < nt; t += 2) {
            const bool last = (t == nt - 2);
            const char* a1 = cA + (size_t)(t + 1) * kstep;
            const char* a2 = last ? nA : cA + (size_t)(t + 2) * kstep; const char* b2 = last ? nB : cB + (size_t)(t + 2) * kstep;
            const char* a3 = a2 + kstep; const char* b3 = b2 + kstep;
            PG8_LDB(B0, 0, 0); PG8_LDB(B1, 0, 1); PG8_SCHED; PG8_LDA(At, 0, 0); PG8_STAGE(PG8_SA(1, 1), a1 + hstepA, voffA);
            PG8_WAIT_V(8); PG8_WAIT_L(0); PG8_BAR; PG8_MMA(0, 0, At, B0); PG8_MMA(0, 1, At, B1); PG8_BAR; PG8_SCHED;
            PG8_LDA(At, 0, 1); PG8_STAGE(PG8_SB(0, 0), b2, voffB); PG8_STAGE(PG8_SB(0, 1), b2 + hstepB, voffB); PG8_STAGE(PG8_SA(0, 0), a2, voffA);
            PG8_WAIT_V(8); PG8_WAIT_L(0); PG8_BAR; PG8_MMA(1, 0, At, B0); PG8_MMA(1, 1, At, B1); PG8_BAR; PG8_SCHED;
            PG8_LDB(B0, 1, 0); PG8_LDB(B1, 1, 1); PG8_SCHED; PG8_LDA(At, 1, 0); PG8_STAGE(PG8_SA(0, 1), a2 + hstepA, voffA);
            PG8_WAIT_V(8); PG8_WAIT_L(0); PG8_BAR; PG8_MMA(0, 0, At, B0); PG8_MMA(0, 1, At, B1); PG8_BAR; PG8_SCHED;
            PG8_LDA(At, 1, 1); PG8_STAGE(PG8_SB(1, 0), b3, voffB); PG8_STAGE(PG8_SB(1, 1), b3 + hstepB, voffB); PG8_STAGE(PG8_SA(1, 0), a3, voffA);
            PG8_WAIT_V(8); PG8_WAIT_L(0); PG8_BAR; PG8_MMA(1, 0, At, B0); PG8_MMA(1, 1, At, B1); PG8_BAR; PG8_SCHED;
        }
        if constexpr (ALIGN_EPI) { if (wr == 0) PG8_BAR; }
        E(acc, cur, ui, wr, wc, fr, fq, lds);
        if (!has_next) break;
#pragma unroll
        for (int a = 0; a < 2; ++a)
#pragma unroll
            for (int b = 0; b < 2; ++b)
#pragma unroll
                for (int m = 0; m < 4; ++m)
#pragma unroll
                    for (int n = 0; n < 2; ++n) acc[a][b][m][n] = (f32x4){0.f, 0.f, 0.f, 0.f};
        cur = nxt; cA = nA; cB = nB; ++ui;
        if constexpr (ALIGN_EPI) { if (wr == 1) PG8_BAR; }
    }
    PG8_WAIT_V(0);
    if constexpr (!ALIGN_EPI) { if (wr == 0) PG8_BAR; }
    PG8_BAR;
#undef G_ABASE
#undef G_BBASE
#undef PG8_SA
#undef PG8_SB
#undef PG8_STAGE
#undef PG8_LDA
#undef PG8_LDB
#undef PG8_MMA
#undef PG8_WAIT_V
#undef PG8_WAIT_L
#undef PG8_BAR
#undef PG8_SCHED
}

enum { MAP_ID = 0, MAP_GATE = 1, MAP_UP = 2, MAP_WIN = 3 };
__device__ __forceinline__ int map_row(int kind, int n) {
    if (kind == MAP_GATE) return 256 * (n >> 7) + (n & 127);
    if (kind == MAP_UP) return 256 * (n >> 7) + 128 + (n & 127);
    if (kind == MAP_WIN) {
        if (n < 512) { const int head = n >> 6, d = n & 63, tile = head >> 2, hh = head & 3; return 256 * tile + (d < 32 ? 32 * hh + d : 128 + 32 * hh + d - 32); }
        if (n < 640) { const int kh = (n - 512) >> 6, d = n & 63; return 512 + (d < 32 ? 32 * kh + d : 128 + 32 * kh + d - 32); }
        if (n < 768) { const int vc = n - 640; return 512 + (vc < 64 ? 64 + vc : 128 + 64 + (vc - 64)); }
        return n;
    }
    return n;
}
__device__ __forceinline__ void conv_item(const float* W, const float* gain, int K, int N, bf16_t* WT, int kind, bool hm, LAS float* scr, int item, int lane) {
    const int nblk = N / 32, kb = item / nblk, nb = item % nblk, k0 = 64 * kb, n0 = 32 * nb;
    {
        const int kr = lane >> 3, c4 = lane & 7; f32x4 v[8]; float gv[8];
#pragma unroll
        for (int i = 0; i < 8; ++i) { v[i] = *(const f32x4*)(W + (size_t)(k0 + 8 * i + kr) * N + n0 + 4 * c4); gv[i] = gain ? gain[k0 + 8 * i + kr] : 1.0f; }
#pragma unroll
        for (int i = 0; i < 8; ++i) { LAS float* d = scr + (8 * i + kr) * 33 + 4 * c4; d[0] = v[i].x * gv[i]; d[1] = v[i].y * gv[i]; d[2] = v[i].z * gv[i]; d[3] = v[i].w * gv[i]; }
    }
    asm volatile("s_waitcnt lgkmcnt(0)" ::: "memory");
    const int c = lane & 7;
#pragma unroll
    for (int j = 0; j < 4; ++j) { const int n = (lane >> 3) + 8 * j; const LAS float* s = scr + (8 * c) * 33 + n;
        u32x4 o; o.x = cvt_pk_bf16(s[0 * 33], s[1 * 33]); o.y = cvt_pk_bf16(s[2 * 33], s[3 * 33]); o.z = cvt_pk_bf16(s[4 * 33], s[5 * 33]); o.w = cvt_pk_bf16(s[6 * 33], s[7 * 33]);
        const int kc = k0 + 8 * c; bf16_t* dp = hm ? WT + ((size_t)(kc >> 8) * N + n0 + n) * 256 + (kc & 255) : WT + (size_t)map_row(kind, n0 + n) * K + kc;
        *(u32x4*)dp = o; }
    asm volatile("s_waitcnt lgkmcnt(0)" ::: "memory");
}

struct Params { const float* in[25]; float* out; unsigned char* ws; int ph_lo, ph_hi; };

__device__ __forceinline__ void prologue(const Params& p, LAS unsigned char* lds) {
    int tid_ = threadIdx.x; asm volatile("" : "+v"(tid_));
    const int tid = tid_, lane = tid & 63, wave = __builtin_amdgcn_readfirstlane(tid >> 6);
    LAS float* scr = (LAS float*)(lds + wave * 16384);
    const int gw = blockIdx.x * 8 + wave, NGW = gridDim.x * 8;
    unsigned char* ws = p.ws;
    constexpr int IPL = 1408 * 6 + 640 + 512 * 2 + 1024 + 32;
    for (int it = gw; it < 2 * IPL; it += NGW) {
        const int l = it / IPL; int r = it % IPL; size_t wl_extra = 0;
        unsigned char* wl = ws + OFF_W + (size_t)l * WL_BYTES;
        int wi, gi = -1, K = 1024, N = 1024, kind = MAP_ID; size_t wstride = SLOT, doff; bool in_wl = true, hm = false;
        if (r < 1408) { wi = 4; gi = 3; N = FF; kind = MAP_GATE; wstride = (size_t)DM * FF; doff = WO_GU1; }
        else if ((r -= 1408) < 1408) { wi = 5; gi = 3; N = FF; kind = MAP_UP; wstride = (size_t)DM * FF; doff = WO_GU1; }
        else if ((r -= 1408) < 1408) { wi = 6; K = FF; wstride = (size_t)DM * FF; doff = WO_D1; }
        else if ((r -= 1408) < 640) { wi = 8; gi = 7; N = INW; kind = MAP_WIN; wstride = (size_t)DM * INW; doff = WO_IN; }
        else if ((r -= 640) < 512) { wi = 14; doff = WO_OUT; }
        else if ((r -= 512) < 1024) { wi = 18; N = 2048; wstride = 2 * SLOT; in_wl = false; doff = OFF_WKV + (size_t)l * 2 * SLOT * 2; }
        else if ((r -= 1024) < 512) { wi = 19; in_wl = false; hm = true; doff = OFF_WOT + (size_t)l * SLOT * 2; }
        else if ((r -= 512) < 1408) { wi = 21; gi = 20; N = FF; kind = MAP_GATE; wstride = (size_t)DM * FF; doff = WO_GU2; }
        else if ((r -= 1408) < 1408) { wi = 22; gi = 20; N = FF; kind = MAP_UP; wstride = (size_t)DM * FF; doff = WO_GU2; }
        else if ((r -= 1408) < 1408) { wi = 23; K = FF; wstride = (size_t)DM * FF; doff = WO_D2; }
        else { r -= 1408; const int g4 = r >> 3; r &= 7; wi = 10; K = 128; N = 128; wstride = 4 * 128 * 128; doff = WO_PW + (size_t)g4 * 128 * 128 * 2; wl_extra = (size_t)g4 * 128 * 128; }
        const float* W = (wi == 4 ? p.in[4] : wi == 5 ? p.in[5] : wi == 6 ? p.in[6] : wi == 8 ? p.in[8] : wi == 14 ? p.in[14] : wi == 18 ? p.in[18] : wi == 19 ? p.in[19] : wi == 21 ? p.in[21] : wi == 22 ? p.in[22] : wi == 23 ? p.in[23] : p.in[10]) + (size_t)l * wstride + wl_extra;
        const float* gain = gi < 0 ? nullptr : (gi == 3 ? p.in[3] : gi == 7 ? p.in[7] : p.in[20]) + l * DM;
        bf16_t* dst = (bf16_t*)((in_wl ? wl : ws) + doff);
        conv_item(W, gain, K, N, dst, kind, hm, scr, r, lane);
    }
    for (int it = gw; it < 2 * 1024; it += NGW) {
        const int l = it >> 10, row = it & 1023;
        const f32x4* xr = (const f32x4*)(p.in[1] + (size_t)row * DM) + lane; const f32x4* gr = (const f32x4*)(p.in[16] + l * DM) + lane;
        f32x4 v[4]; float s = 0.f;
#pragma unroll
        for (int j = 0; j < 4; ++j) { v[j] = xr[64 * j]; s += (v[j].x * v[j].x + v[j].y * v[j].y) + (v[j].z * v[j].z + v[j].w * v[j].w); }
        const float r = rsqrtf(wave_sum(s) * (1.0f / 1024.0f) + EPS);
        bf16_t* oa = (bf16_t*)(ws + OFF_MEMN) + (size_t)l * SLOT + (size_t)row * DM;
#pragma unroll
        for (int j = 0; j < 4; ++j) { const f32x4 g = gr[64 * j]; u32x2 w; w.x = cvt_pk_bf16(v[j].x * r * g.x, v[j].y * r * g.y); w.y = cvt_pk_bf16(v[j].z * r * g.z, v[j].w * r * g.w);
            *((u32x2*)oa + lane + 64 * j) = w; }
    }
    for (int it = gw; it < 2 * 1024; it += NGW) {
        const int l = it >> 10, k = it & 1023;
        const f32x4* xr = (const f32x4*)(p.in[17] + (size_t)l * SLOT + (size_t)k * DM) + lane; const float g = p.in[15][l * DM + k];
        bf16_t* o = (bf16_t*)(ws + OFF_WQN) + (size_t)l * SLOT + (size_t)k * 256;
#pragma unroll
        for (int j = 0; j < 4; ++j) { const f32x4 v = xr[64 * j]; u32x2 w; w.x = cvt_pk_bf16(v.x * g, v.y * g); w.y = cvt_pk_bf16(v.z * g, v.w * g);
            *((u32x2*)(o + (size_t)j * 1024 * 256) + lane) = w; }
    }
    for (int rb = gw * 4; rb < MT; rb += NGW * 4) {
        f32x4 v[4][4];
#pragma unroll
        for (int q = 0; q < 4; ++q) { const f32x4* xr = (const f32x4*)(p.in[0] + (size_t)(rb + q) * DM) + lane;
#pragma unroll
            for (int j = 0; j < 4; ++j) v[q][j] = xr[64 * j]; }
#pragma unroll
        for (int q = 0; q < 4; ++q) { float s = 0.f;
#pragma unroll
            for (int j = 0; j < 4; ++j) s += (v[q][j].x * v[q][j].x + v[q][j].y * v[q][j].y) + (v[q][j].z * v[q][j].z + v[q][j].w * v[q][j].w);
            s = wave_sum(s);
            bf16_t* o = (bf16_t*)(ws + OFF_XB) + (size_t)(rb + q) * DM;
#pragma unroll
            for (int j = 0; j < 4; ++j) { u32x2 w; w.x = cvt_pk_bf16(v[q][j].x, v[q][j].y); w.y = cvt_pk_bf16(v[q][j].z, v[q][j].w); *((u32x2*)o + lane + 64 * j) = w; }
            if (lane < 4) ((float*)(ws + OFF_SSQ))[(size_t)(rb + q) * 4 + lane] = (lane == 0) ? s : 0.f; }
    }
    {
        const int* pos = (const int*)p.in[2]; float* cs = (float*)(ws + OFF_COS); float* sn = (float*)(ws + OFF_SIN);
        const int gt = blockIdx.x * 512 + tid, NGT = gridDim.x * 512;
        for (int i = gt; i < MT * 32; i += NGT) { const int row = i >> 5, f = i & 31;
            const float inv = powf(10000.0f, -(float)(2 * f) / 64.0f); const float ang = (float)pos[row] * inv;
            cs[i] = cosf(ang); sn[i] = sinf(ang); }
    }
}

constexpr int MX_KS = 0, MX_KSTR = 272, MX_VT = 160 * 272, MX_VSTR = 328, MX_XA = 86016, MX_XB = 87040;
constexpr int MX_US = 88064, MX_PL = 0, MX_PSTR = 1040;
static_assert(MX_VT + 128 * MX_VSTR <= MX_XA && MX_PL + 32 * MX_PSTR <= MX_VT && MX_US + 47 * 1024 <= LDS_BYTES, "mixer LDS map");
__device__ __forceinline__ int crow(int r, int hi) { return (r & 3) + 8 * (r >> 2) + 4 * hi; }

template <int W> __device__ __forceinline__ void pool_w(const LAS unsigned* U, LAS unsigned char* pl, int t0, int ts, int cp) {
    unsigned uu[16 + W - 1];
#pragma unroll
    for (int i = 0; i < 16 + W - 1; ++i) uu[i] = U[(ts + 15 - (W - 1) + i) * 256];
    float s0 = 0.f, s1 = 0.f;
#pragma unroll
    for (int i = 0; i < W - 1; ++i) { s0 += bf_lo(uu[i]); s1 += bf_hi(uu[i]); }
#pragma unroll
    for (int t = 0; t < 16; ++t) {
        const float c0 = bf_lo(uu[W - 1 + t]), c1 = bf_hi(uu[W - 1 + t]); s0 += c0; s1 += c1;
        const int tp = t0 + ts + t + 1; const float inv = (tp < W) ? 1.0f / (float)tp : 1.0f / (float)W;
        *(LAS unsigned*)(pl + (ts + t) * MX_PSTR + cp * 4) = cvt_pk_bf16(s0 * inv - c0, s1 * inv - c1);
        s0 -= bf_lo(uu[t]); s1 -= bf_hi(uu[t]);
    }
}
constexpr int MX_TAB = LDS_RS;
static_assert(MX_TAB + 3 * 2048 <= LDS_BYTES && MX_US + 47 * 1024 <= LDS_BARST && MX_TAB > LDS_BARST + 16, "mixer LDS map (tables)");

#define MX_BAR() do { asm volatile("s_waitcnt lgkmcnt(0)" ::: "memory"); __builtin_amdgcn_s_barrier(); asm volatile("" ::: "memory"); } while (0)
__device__ __forceinline__ void mixer_phase(LAS unsigned char* lds, const bf16_t* proj, const bf16_t* qfg, const bf16_t* vtg, bf16_t* mrg, const bf16_t* pwT, const float* sinks, const float* gA, const float* gB, const float* pscale) {
    int tid_ = threadIdx.x;
    {
        asm volatile("" : "+v"(tid_));
        LAS float* tab = (LAS float*)(lds + MX_TAB);
        tab[tid_] = gA[tid_]; tab[512 + tid_] = gB[tid_]; tab[1024 + tid_] = pscale[tid_];
    }
    const int vcu = (int)((volatile LAS unsigned*)(lds + LDS_BARST))[2];
    for (int unit0 = vcu; unit0 < MT / 32; unit0 += gridDim.x) {
        const int unit = (gridDim.x == 256) ? 128 * (vcu & 7) + (vcu >> 3) + 32 * (unit0 >> 8) : unit0;
        asm volatile("" : "+v"(tid_));
        const int tid = tid_, lane = tid & 63, wid = __builtin_amdgcn_readfirstlane(tid >> 6), r32 = lane & 31, hi = lane >> 5;
        const int b = unit >> 8, t0 = (unit & 255) * 32; const size_t row0 = (size_t)b * SEQ + t0;
#pragma unroll
        for (int i = 0; i < 5; ++i) { const int idx = tid + 512 * i, key = idx >> 4, ch = idx & 15; u32x4 v = (u32x4){0u, 0u, 0u, 0u};
            if (t0 - 128 + key >= 0) v = *(const u32x4*)(proj + (row0 - 128 + key) * INW + 512 + ch * 8);
            *(LAS u32x4*)(lds + MX_KS + key * MX_KSTR + ch * 16) = v; }
#pragma unroll
        for (int i = 0; i < 5; ++i) { const int idx = tid + 512 * i, chn = idx / 20, key0 = (idx % 20) * 8; u32x4 v = (u32x4){0u, 0u, 0u, 0u};
            if (t0 - 128 + key0 >= 0) v = *(const u32x4*)(vtg + ((size_t)b * 128 + chn) * SEQ + (t0 - 128 + key0));
            LAS u32x2* vt = (LAS u32x2*)(lds + MX_VT + chn * MX_VSTR + key0 * 2); vt[0] = (u32x2){v.x, v.y}; vt[1] = (u32x2){v.z, v.w}; }
#pragma unroll
        for (int i = 0; i < 6; ++i) { const int idx = tid + 512 * i; if (idx < 47 * 64) { const int lr = idx >> 6, ch = idx & 63; u32x4 v = (u32x4){0u, 0u, 0u, 0u};
                if (t0 + lr - 15 >= 0) v = *(const u32x4*)(proj + (row0 + lr - 15) * INW + 768 + ch * 8);
                *(LAS u32x4*)(lds + MX_US + lr * 1024 + ch * 16) = v; } }
        bf16x8 qf[4];
#pragma unroll
        for (int ks = 0; ks < 4; ++ks) qf[ks] = *(const bf16x8*)(qfg + ((((size_t)unit * 8 + wid) * 4 + ks) * 2 + hi) * 256 + r32 * 8);
        MX_BAR();
        const int kvh = wid >> 2;
        f32x16 s[5];
#pragma unroll
        for (int kt = 0; kt < 5; ++kt) {
            f32x16 a = (f32x16){0.f, 0.f, 0.f, 0.f, 0.f, 0.f, 0.f, 0.f, 0.f, 0.f, 0.f, 0.f, 0.f, 0.f, 0.f, 0.f};
#pragma unroll
            for (int ks = 0; ks < 4; ++ks) { const bf16x8 kf = *(const LAS bf16x8*)(lds + MX_KS + (32 * kt + r32) * MX_KSTR + (kvh * 64 + ks * 16 + hi * 8) * 2);
                a = __builtin_amdgcn_mfma_f32_32x32x16_bf16(kf, qf[ks], a, 0, 0, 0); }
            s[kt] = a;
        }
        const float sink2 = sinks[wid] * LOG2E;
        float mx = sink2;
        if (t0 >= 128) {
#pragma unroll
            for (int r = 0; r < 16; ++r) { const int k0 = crow(r, hi); if (k0 <= r32) s[0][r] = -1.0e30f; if (k0 > r32) s[4][r] = -1.0e30f; }
        } else {
#pragma unroll
            for (int kt = 0; kt < 5; ++kt)
#pragma unroll
                for (int r = 0; r < 16; ++r) { const int kk = 32 * kt + crow(r, hi); const int diff = (128 + r32) - kk;
                    const bool ok = (diff >= 0) && (diff < 128) && (t0 - 128 + kk >= 0); if (!ok) s[kt][r] = -1.0e30f; }
        }
#pragma unroll
        for (int kt = 0; kt < 5; ++kt)
#pragma unroll
            for (int r = 0; r < 16; ++r) mx = fmaxf(mx, s[kt][r]);
        mx = fmaxf(mx, __shfl_xor(mx, 32));
        float lsum = 0.f;
#pragma unroll
        for (int kt = 0; kt < 5; ++kt)
#pragma unroll
            for (int r = 0; r < 16; ++r) { const float e = __builtin_amdgcn_exp2f(s[kt][r] - mx); s[kt][r] = e; lsum += e; }
        lsum += __shfl_xor(lsum, 32); lsum += __builtin_amdgcn_exp2f(sink2 - mx);
        const float linv = 1.0f / lsum;
        f32x16 o[2];
#pragma unroll
        for (int dh = 0; dh < 2; ++dh) {
            f32x16 a = (f32x16){0.f, 0.f, 0.f, 0.f, 0.f, 0.f, 0.f, 0.f, 0.f, 0.f, 0.f, 0.f, 0.f, 0.f, 0.f, 0.f};
            const LAS unsigned char* vrow = lds + MX_VT + (kvh * 64 + 32 * dh + r32) * MX_VSTR;
#pragma unroll
            for (int kt = 0; kt < 5; ++kt)
#pragma unroll
                for (int st = 0; st < 2; ++st) {
                    const int key0 = 32 * kt + 16 * st + 4 * hi;
                    const u32x2 v0 = *(const LAS u32x2*)(vrow + key0 * 2), v1 = *(const LAS u32x2*)(vrow + (key0 + 8) * 2);
                    u32x4 av; av.x = v0.x; av.y = v0.y; av.z = v1.x; av.w = v1.y;
                    u32x4 pv; pv.x = cvt_pk_bf16(s[kt][8 * st + 0], s[kt][8 * st + 1]); pv.y = cvt_pk_bf16(s[kt][8 * st + 2], s[kt][8 * st + 3]);
                    pv.z = cvt_pk_bf16(s[kt][8 * st + 4], s[kt][8 * st + 5]); pv.w = cvt_pk_bf16(s[kt][8 * st + 6], s[kt][8 * st + 7]);
                    a = __builtin_amdgcn_mfma_f32_32x32x16_bf16(__builtin_bit_cast(bf16x8, av), __builtin_bit_cast(bf16x8, pv), a, 0, 0, 0);
                    if (st) __builtin_amdgcn_sched_barrier(0);
                }
            o[dh] = a;
        }
        float q2 = 0.f;
#pragma unroll
        for (int dh = 0; dh < 2; ++dh)
#pragma unroll
            for (int r = 0; r < 16; ++r) { const float v = o[dh][r] * linv; o[dh][r] = v; q2 += v * v; }
        q2 += __shfl_xor(q2, 32);
        if (hi == 0) ((LAS float*)(lds + MX_XA))[wid * 32 + r32] = q2;
        MX_BAR();
        {
            float tot = 0.f;
#pragma unroll
            for (int w = 0; w < 8; ++w) tot += ((LAS float*)(lds + MX_XA))[w * 32 + r32];
            const float rA = rsqrtf(tot * (1.0f / 512.0f) + EPS);
            bf16_t* orow = mrg + drow(row0 + r32) + wid * 64;
#pragma unroll
            for (int dh = 0; dh < 2; ++dh)
#pragma unroll
                for (int pq = 0; pq < 2; ++pq) { u32x2 w2[2];
#pragma unroll
                    for (int h2 = 0; h2 < 2; ++h2) { const int rq = 2 * pq + h2, d0 = 32 * dh + 8 * rq + 4 * hi; const f32x4 g = *(const LAS f32x4*)(lds + MX_TAB + (wid * 64 + d0) * 4);
                        w2[h2].x = cvt_pk_bf16(o[dh][4 * rq + 0] * rA * g.x, o[dh][4 * rq + 1] * rA * g.y); w2[h2].y = cvt_pk_bf16(o[dh][4 * rq + 2] * rA * g.z, o[dh][4 * rq + 3] * rA * g.w); }
                    *(u32x4*)(orow + 32 * dh + 16 * pq + 8 * hi) = pair16(w2[0], w2[1]); }
        }
        bf16x8 wf[2][8];
#pragma unroll
        for (int e = 0; e < 2; ++e)
#pragma unroll
            for (int ks = 0; ks < 8; ++ks) wf[e][ks] = *(const bf16x8*)(pwT + ((size_t)((wid >> 1) * 128 + 32 * (2 * (wid & 1) + e) + r32)) * 128 + hi * 8 + ks * 16);
        {
            const int cp = tid & 255, ts = 16 * (tid >> 8), gsel = __builtin_amdgcn_readfirstlane(cp >> 6);
            const LAS unsigned* U = (const LAS unsigned*)(lds + MX_US) + cp;
            if (gsel == 0) pool_w<2>(U, lds + MX_PL, t0, ts, cp); else if (gsel == 1) pool_w<4>(U, lds + MX_PL, t0, ts, cp);
            else if (gsel == 2) pool_w<8>(U, lds + MX_PL, t0, ts, cp); else pool_w<16>(U, lds + MX_PL, t0, ts, cp);
        }
        MX_BAR();
        {
            const int g = wid >> 1, nh = wid & 1;
            f32x16 acc2[2];
#pragma unroll
            for (int e = 0; e < 2; ++e) {
                f32x16 a = (f32x16){0.f, 0.f, 0.f, 0.f, 0.f, 0.f, 0.f, 0.f, 0.f, 0.f, 0.f, 0.f, 0.f, 0.f, 0.f, 0.f};
#pragma unroll
                for (int ks = 0; ks < 8; ++ks) { const bf16x8 af = wf[e][ks];
                    const bf16x8 bfr = *(const LAS bf16x8*)(lds + MX_PL + r32 * MX_PSTR + (g * 128 + ks * 16 + hi * 8) * 2);
                    a = __builtin_amdgcn_mfma_f32_32x32x16_bf16(af, bfr, a, 0, 0, 0); }
                acc2[e] = a;
            }
            float q3 = 0.f;
#pragma unroll
            for (int e = 0; e < 2; ++e)
#pragma unroll
                for (int rq = 0; rq < 4; ++rq) { const int ch = g * 128 + 32 * (2 * nh + e) + 8 * rq + 4 * hi; const f32x4 sc = *(const LAS f32x4*)(lds + MX_TAB + (1024 + ch) * 4);
#pragma unroll
                    for (int j = 0; j < 4; ++j) { const float v = acc2[e][4 * rq + j] * sc[j]; acc2[e][4 * rq + j] = v; q3 += v * v; } }
            q3 += __shfl_xor(q3, 32);
            if (hi == 0) ((LAS float*)(lds + MX_XB))[wid * 32 + r32] = q3;
            MX_BAR();
            float tot = 0.f;
#pragma unroll
            for (int w = 0; w < 8; ++w) tot += ((LAS float*)(lds + MX_XB))[w * 32 + r32];
            const float rB = rsqrtf(tot * (1.0f / 512.0f) + EPS);
            bf16_t* orow = mrg + drow(row0 + r32) + 512;
#pragma unroll
            for (int e = 0; e < 2; ++e)
#pragma unroll
                for (int pq = 0; pq < 2; ++pq) { u32x2 w2[2];
#pragma unroll
                    for (int h2 = 0; h2 < 2; ++h2) { const int rq = 2 * pq + h2, ch = g * 128 + 32 * (2 * nh + e) + 8 * rq + 4 * hi; const f32x4 gg = *(const LAS f32x4*)(lds + MX_TAB + (512 + ch) * 4);
                        w2[h2].x = cvt_pk_bf16(acc2[e][4 * rq + 0] * rB * gg.x, acc2[e][4 * rq + 1] * rB * gg.y); w2[h2].y = cvt_pk_bf16(acc2[e][4 * rq + 2] * rB * gg.z, acc2[e][4 * rq + 3] * rB * gg.w); }
                    *(u32x4*)(orow + g * 128 + 32 * (2 * nh + e) + 16 * pq + 8 * hi) = pair16(w2[0], w2[1]); }
        }
    }
}

#define XB_TMO      128
#define XB_XCNT(j)  (256  + 64 * (j))
#define XB_XSUB(j)  (1280 + 64 * (j))
#define XB_XGEN(j)  (2304 + 64 * (j))
#define XB_TOP      3328
#define XB_TOPGEN   3392
#define XCD_BAR_WORDS 3456
#define XB_SPIN_CAP (1u << 18)

__device__ __forceinline__ unsigned xb_ld(unsigned* p)              { return __hip_atomic_load(p, __ATOMIC_RELAXED, __HIP_MEMORY_SCOPE_AGENT); }
__device__ __forceinline__ unsigned xb_add(unsigned* p, unsigned v) { return __hip_atomic_fetch_add(p, v, __ATOMIC_RELAXED, __HIP_MEMORY_SCOPE_AGENT); }
__device__ __forceinline__ unsigned xb_xcc_id() { return (unsigned)__builtin_amdgcn_s_getreg((3 << 11) | 20) & 0xFu; }
#define XB_SPIN(cond, bar) do { unsigned _sp = 0; while (cond) { __builtin_amdgcn_s_sleep(1); \
    if ((++_sp & 255u) == 0u) { if (xb_ld(&(bar)[XB_TMO])) break; if (_sp > XB_SPIN_CAP) { atomicAdd(&(bar)[XB_TMO], 1u); break; } } } } while (0)

struct XcdBarrier {
    unsigned* bar; unsigned x;
    volatile LAS unsigned* st;
};

__device__ __forceinline__ XcdBarrier xcd_barrier_post(unsigned* bar, volatile LAS unsigned* st) {
    XcdBarrier b; b.bar = bar; b.x = xb_xcc_id(); b.st = st;
    if (threadIdx.x == 0) (void)xb_add(&bar[XB_XCNT(b.x)], 1u);
    return b;
}
__device__ __forceinline__ void xcd_barrier_complete(unsigned* bar, unsigned x, unsigned& nloc, unsigned& nx) {
    const unsigned G = gridDim.x * gridDim.y * gridDim.z;
    unsigned sum, cnt, mine, sp = 0u;
    for (;;) {
        sum = 0u; cnt = 0u; mine = 0u;
#pragma unroll
        for (unsigned j = 0; j < 16; ++j) { const unsigned c = xb_ld(&bar[XB_XCNT(j)]); sum += c; cnt += (c > 0u) ? 1u : 0u; mine = (j == x) ? c : mine; }
        if (sum == G) break;
        __builtin_amdgcn_s_sleep(1);
        if ((++sp & 255u) == 0u) { if (xb_ld(&bar[XB_TMO])) break; if (sp > XB_SPIN_CAP) { atomicAdd(&bar[XB_TMO], 1u); break; } }
    }
    nloc = mine > 0u ? mine : 1u; nx = cnt > 0u ? cnt : 1u;
}

__device__ __forceinline__ void xcd_barrier(const XcdBarrier& b) {
    asm volatile("s_waitcnt vmcnt(0)" ::: "memory");
    __syncthreads();
    if (threadIdx.x == 0) {
        unsigned* bar = b.bar;
        __builtin_amdgcn_s_waitcnt(0);
        unsigned nloc = b.st[0], nx = b.st[1];
        if (nloc == 0u) { xcd_barrier_complete(bar, b.x, nloc, nx); b.st[0] = nloc; b.st[1] = nx; }
        const unsigned old = xb_add(&bar[XB_XSUB(b.x)], 1u);
        const unsigned gen = old / nloc;
        if (old + 1u == (gen + 1u) * nloc) {
            __builtin_amdgcn_fence(__ATOMIC_RELEASE, "agent");
            asm volatile("s_waitcnt vmcnt(0)" ::: "memory");
            const unsigned og = xb_add(&bar[XB_TOP], 1u);
            const unsigned tg = og / nx;
            if (og + 1u == (tg + 1u) * nx) xb_add(&bar[XB_TOPGEN], 1u);
            else XB_SPIN(xb_ld(&bar[XB_TOPGEN]) == tg, bar);
            __builtin_amdgcn_fence(__ATOMIC_ACQUIRE, "agent");
            xb_add(&bar[XB_XGEN(b.x)], 1u);
            asm volatile("s_waitcnt vmcnt(0)" ::: "memory");
        } else {
            XB_SPIN(xb_ld(&bar[XB_XGEN(b.x)]) == gen, bar);
            __builtin_amdgcn_fence(__ATOMIC_ACQUIRE, "agent");
            asm volatile("s_waitcnt vmcnt(0)" ::: "memory");
        }
    }
    __syncthreads();
}

#define XL_SUB(j)   (3456 + 64 * (j))
#define XL_GEN(j)   (3456 + 1024 + 64 * (j))
__device__ __forceinline__ void xcd_local_barrier(unsigned* bar, unsigned x, unsigned nloc) {
    asm volatile("s_waitcnt vmcnt(0)" ::: "memory");
    __syncthreads();
    if (threadIdx.x == 0) {
        __builtin_amdgcn_s_waitcnt(0);
        const unsigned old = xb_add(&bar[XL_SUB(x)], 1u);
        const unsigned gen = old / nloc;
        if (old + 1u == (gen + 1u) * nloc) xb_add(&bar[XL_GEN(x)], 1u);
        else XB_SPIN(xb_ld(&bar[XL_GEN(x)]) == gen, bar);
        __builtin_amdgcn_fence(__ATOMIC_ACQUIRE, "agent");
        asm volatile("s_waitcnt vmcnt(0)" ::: "memory");
    }
    __syncthreads();
}

constexpr int N_HEAD = 1, N_SUB = 9, N_PHASES = N_HEAD + 2 * N_SUB + 1;
__global__ void __launch_bounds__(512) hymba_fwd(Params p) {
    extern __shared__ __attribute__((aligned(16))) unsigned char lds_raw[];
    LAS unsigned char* lds = (LAS unsigned char*)lds_raw;
    unsigned char* ws = p.ws;
    bf16_t* XB = (bf16_t*)(ws + OFF_XB); bf16_t* ACT = (bf16_t*)(ws + OFF_ACT); bf16_t* PROJ = (bf16_t*)(ws + OFF_PROJ); bf16_t* MRG = (bf16_t*)((unsigned char*)p.out + DO_MRG); bf16_t* PB = (bf16_t*)((unsigned char*)p.out + DO_P);
    float* SSQ = (float*)(ws + OFF_SSQ);
    const size_t BIG = (size_t)256 * 1024;
    volatile LAS unsigned* MISCW = (volatile LAS unsigned*)(lds + LDS_BARST);
    if (threadIdx.x < 8) MISCW[threadIdx.x] = (threadIdx.x == 2) ? blockIdx.x : 0u;
    __syncthreads();
    if (threadIdx.x == 0) { const unsigned x_ = xb_xcc_id(); MISCW[5] = x_; MISCW[4] = xb_add(&((unsigned*)(ws + OFF_CTL))[XB_XCNT(x_)], 1u); }
    if (p.ph_lo <= 0 && 0 < p.ph_hi) { for (int rep = 0; rep <= PROBE_PRO; ++rep) { if (rep) GSYNC(); prologue(p, lds); __syncthreads(); } }
    bool synced = false;
    if (p.ph_lo == 0 && p.ph_hi > 1) {
        GSYNC(); synced = true;
        if (threadIdx.x == 0) {
            unsigned* bar = (unsigned*)(ws + OFF_CTL); bool ok = (gridDim.x == 256);
            for (unsigned j = 0; j < 16; ++j) { const unsigned c = xb_ld(&bar[XB_XCNT(j)]); ok = ok && (c == (j < 8 ? 32u : 0u)); }
            if (ok && MISCW[4] < 32u && MISCW[5] < 8u) { MISCW[2] = MISCW[4] * 8u + MISCW[5]; MISCW[3] = 1u; }
        }
        __syncthreads();
    }
    const int ph_a = p.ph_lo > N_HEAD ? p.ph_lo : N_HEAD, ph_b = p.ph_hi < N_PHASES - 1 ? p.ph_hi : N_PHASES - 1;
    for (int ph = ph_a; ph < ph_b; ++ph) {
        const int l = (ph - N_HEAD) / N_SUB, sp = (ph - N_HEAD) % N_SUB;
        for (int rep = 0; rep <= ((PROBE_MASK >> sp) & 1); ++rep) {
        if (rep || (ph > p.ph_lo && !(synced && ph == N_HEAD))) SEAM(!rep && !(l == 0 && sp == 0) && sp != 3 && !(sp == 4 && l == 0));
        unsigned char* wl = ws + OFF_W + (size_t)l * WL_BYTES;
        if (sp == 0 || sp == 7) {
            Gemm g{XB, (const bf16_t*)(wl + (sp == 0 ? WO_GU1 : WO_GU2)), 1024, 1024, 1024, 128, 22, 1 << 30, BIG, 0, 0, BIG, 0, 0};
            EpiGateUp E{SSQ, ACT};
            gemm_phase<EpiGateUp>(lds, g, E);
        } else if (sp == 1 || sp == 8 || sp == 4 || sp == 6) {
            Gemm g;
            if (sp == 1 || sp == 8) g = Gemm{ACT, (const bf16_t*)(wl + (sp == 1 ? WO_D1 : WO_D2)), FF, FF, FF, 128, 4, 1 << 30, (size_t)256 * FF, 0, 0, (size_t)256 * FF, 0, 0};
            else if (sp == 4) g = Gemm{MRG, (const bf16_t*)(wl + WO_OUT), 1024, 1024, 1024, 128, 4, 1 << 30, BIG, (size_t)1 << 23, 0, BIG, 0, 0, 16};
            else g = Gemm{PB, (const bf16_t*)(ws + OFF_WVO) + (size_t)l * 4 * SLOT, 1024, 1024, 1024, 128, 4, 32, BIG, (size_t)1 << 23, 0, BIG, SLOT, 0, 16};
            EpiResid E{XB, SSQ, (sp == 1 || sp == 8) ? 0.5f : 1.0f};
            gemm_phase<EpiResid>(lds, g, E);
        } else if (sp == 2) {
            Gemm g{XB, (const bf16_t*)(wl + WO_IN), 1024, 1024, 1024, 128, 5, 1 << 30, BIG, 0, 0, BIG, 0, 0};
            EpiWin E{SSQ, (const float*)(ws + OFF_COS), (const float*)(ws + OFF_SIN), PROJ, (bf16_t*)(ws + OFF_QF), (bf16_t*)(ws + OFF_VTG)};
            gemm_phase<EpiWin>(lds, g, E);
        } else if (sp == 3) {
            mixer_phase(lds, PROJ, (const bf16_t*)(ws + OFF_QF), (const bf16_t*)(ws + OFF_VTG), MRG, (const bf16_t*)(wl + WO_PW), p.in[9] + l * 8, p.in[12] + l * 512, p.in[13] + l * 512, p.in[11] + l * 512);
        } else if (sp == 5) {
            Gemm g{XB, (const bf16_t*)(ws + OFF_WQK) + (size_t)l * 4 * SLOT, 1024, 1024, 1024, 128, 4, 32, BIG, 32 * BIG, 0, BIG, SLOT, 0};
            EpiSoftmax E{SSQ, PB, 1024};
            gemm_phase<EpiSoftmax>(lds, g, E);
        }
        const int nbf = (l == 0 && rep == 0) ? (sp == 2 ? 1 : sp == 3 ? 16 : 0) : 0;
        for (int i = 0; i < nbf; ++i) {
            Gemm g; EpiBf16 E;
            if (sp == 2) {
                g = Gemm{(const bf16_t*)(ws + OFF_MEMN), (const bf16_t*)(ws + OFF_WKV), 1024, 1024, 1024, 8, 8, 4, BIG, 4 * BIG, 0, BIG, 2 * SLOT, 128};
                E = EpiBf16{(bf16_t*)(ws + OFF_KVH), 0, 0, 256, 1, 1.0f};
            } else {
                const int lh = i & 7, l2 = lh >> 2, h = lh & 3;
                if (i < 8) {
                    g = Gemm{(const bf16_t*)(ws + OFF_KVH) + (size_t)(lh * 4) * 65536, (const bf16_t*)(ws + OFF_WQN) + (size_t)lh * 262144, 256, 256, 256, 4, 4, 1 << 30, 65536, 0, 0, 65536, 0, 16 * i};
                    E = EpiBf16{(bf16_t*)(ws + OFF_WQK) + (size_t)l2 * 4 * SLOT + (size_t)h * 256 * 1024, SLOT, 256, 1024, 0, QSCALE_X};
                } else {
                    g = Gemm{(const bf16_t*)(ws + OFF_WOT) + (size_t)lh * 262144, (const bf16_t*)(ws + OFF_KVH) + (size_t)(32 + lh * 4) * 65536, 256, 256, 256, 4, 4, 1 << 30, 65536, 0, 0, 65536, 0, 16 * i};
                    E = EpiBf16{(bf16_t*)(ws + OFF_WVO) + (size_t)l2 * 4 * SLOT + (size_t)h * 256, BIG, SLOT, 1024, 0, 1.0f};
                }
            }
            gemm_phase<EpiBf16>(lds, g, E);
        }
        }
    }
    if (p.ph_lo <= N_PHASES - 1 && N_PHASES - 1 < p.ph_hi) {
        if (N_PHASES - 1 > p.ph_lo) SEAM(true);
        int tid_ = threadIdx.x; asm volatile("" : "+v"(tid_));
        const int vcu = (int)MISCW[2]; const int lane = tid_ & 63, gw = vcu * 8 + (tid_ >> 6), NGW = gridDim.x * 8;
        for (int row0 = gw; row0 < MT; row0 += NGW) {
            const int k_ = row0 / NGW;
            const int row = (gridDim.x == 256) ? 4096 * (vcu & 7) + 128 * (vcu >> 3) + 16 * (tid_ >> 6) + k_ : row0;
            const float r = row_rs(SSQ, row); const u32x2* xr = (const u32x2*)(XB + (size_t)row * DM) + lane; f32x4* orow = (f32x4*)(p.out + (size_t)row * DM) + lane; const f32x4* gr = (const f32x4*)p.in[24] + lane;
#pragma unroll
            for (int j = 0; j < 4; ++j) { const u32x2 v = xr[64 * j]; const f32x4 g = gr[64 * j]; orow[64 * j] = (f32x4){bf_lo(v.x) * r * g.x, bf_hi(v.x) * r * g.y, bf_lo(v.y) * r * g.z, bf_hi(v.y) * r * g.w}; }
        }
    }
}

extern "C" void kernel_launch(void* const* d_in, const int* in_sizes, int n_in, void* d_out, int out_size, void* d_ws, size_t ws_size, hipStream_t stream) {
    static int grid = 0;
    if (grid == 0) {
        if (n_in != 25 || out_size != MT * DM || ws_size < WS_END) { fprintf(stderr, "kernel_launch: unexpected shapes (n_in %d out %d ws %zu need %zu)\n", n_in, out_size, ws_size, (size_t)WS_END); grid = -1; return; }
        int dev = 0, cus = 0, per_cu = 0;
        hipGetDevice(&dev); hipDeviceGetAttribute(&cus, hipDeviceAttributeMultiprocessorCount, dev);
        if (hipFuncSetAttribute((const void*)hymba_fwd, hipFuncAttributeMaxDynamicSharedMemorySize, LDS_BYTES) != hipSuccess) { fprintf(stderr, "kernel_launch: hipFuncSetAttribute failed\n"); grid = -1; return; }
        if (hipOccupancyMaxActiveBlocksPerMultiprocessor(&per_cu, (const void*)hymba_fwd, 512, LDS_BYTES) != hipSuccess || per_cu < 1) { fprintf(stderr, "kernel_launch: occupancy query gave %d\n", per_cu); per_cu = 1; }
        (void)hipGetLastError();
        grid = cus;
    }
    if (grid < 0) return;
    Params p{};
    for (int i = 0; i < 25; ++i) p.in[i] = (const float*)d_in[i];
    p.out = (float*)d_out; p.ws = (unsigned char*)d_ws;
#if MK_ONE_LAUNCH
    p.ph_lo = 0; p.ph_hi = N_PHASES;
    if (hipMemsetAsync((char*)d_ws + OFF_CTL, 0, CTL_BYTES, stream) != hipSuccess) { fprintf(stderr, "kernel_launch: memset of the barrier words failed\n"); return; }
    void* args[] = {&p};
    hipError_t e = hipLaunchCooperativeKernel((const void*)hymba_fwd, dim3(grid), dim3(512), args, LDS_BYTES, stream);
    if (e != hipSuccess) fprintf(stderr, "cooperative launch failed: %s (grid %d)\n", hipGetErrorString(e), grid);
#else
    for (int ph = 0; ph < N_PHASES; ++ph) { p.ph_lo = ph; p.ph_hi = ph + 1; hipLaunchKernelGGL(hymba_fwd, dim3(grid), dim3(512), LDS_BYTES, stream, p); }
#endif
}
```

```cpp
#include <hip/hip_runtime.h>
#include <hip/hip_cooperative_groups.h>
#include <cstdio>
#include <cstdint>
namespace cg = cooperative_groups;

#ifndef MK_ONE_LAUNCH
#define MK_ONE_LAUNCH 1
#endif
#ifndef PROBE_MASK
#define PROBE_MASK 0
#endif
#ifndef PROBE_PRO
#define PROBE_PRO 0
#endif
#ifndef PROBE_NSYNC
#define PROBE_NSYNC 1
#endif
#define SEAM(local_ok_) do { if ((local_ok_) && MISCW[3]) { unsigned char* wq2_ = p.ws; asm volatile("" : "+v"(wq2_)); xcd_local_barrier((unsigned*)(wq2_ + OFF_CTL), MISCW[5], 32u); } else GSYNC(); } while (0)
#define GSYNC() do { for (int s_ = 0; s_ < PROBE_NSYNC; ++s_) { if (p.ph_hi > 4096) cg::this_grid().sync(); else { XcdBarrier gb_; { unsigned char* wq_ = p.ws; asm volatile("" : "+v"(wq_)); gb_.bar = (unsigned*)(wq_ + OFF_CTL); } gb_.x = xb_xcc_id(); gb_.st = (volatile LAS unsigned*)(lds + LDS_BARST); xcd_barrier(gb_); } } } while (0)

#define LAS __attribute__((address_space(3)))
typedef unsigned short bf16_t;
typedef short bf16x8 __attribute__((ext_vector_type(8)));
typedef float f32x4 __attribute__((ext_vector_type(4)));
typedef float f32x16 __attribute__((ext_vector_type(16)));
typedef unsigned u32x4 __attribute__((ext_vector_type(4)));
typedef unsigned u32x2 __attribute__((ext_vector_type(2)));

constexpr int MT = 32768;
constexpr int SEQ = 8192;
constexpr int DM = 1024;
constexpr int FF = 2816;
constexpr int INW = 1280;
constexpr float EPS = 1e-6f;
constexpr float LOG2E = 1.4426950408889634f;
constexpr float QSCALE_SWA = 0.125f * LOG2E;
constexpr float QSCALE_X = 0.0625f * LOG2E;

constexpr size_t SLOT = 1024 * 1024;
constexpr size_t WO_GU1 = 0;
constexpr size_t WO_D1 = WO_GU1 + (size_t)5632 * 1024 * 2;
constexpr size_t WO_IN = WO_D1 + (size_t)1024 * 2816 * 2;
constexpr size_t WO_OUT = WO_IN + (size_t)1280 * 1024 * 2;
constexpr size_t WO_GU2 = WO_OUT + SLOT * 2;
constexpr size_t WO_D2 = WO_GU2 + (size_t)5632 * 1024 * 2;
constexpr size_t WO_PW = WO_D2 + (size_t)1024 * 2816 * 2;
constexpr size_t WL_BYTES = WO_PW + 4 * 128 * 128 * 2;
constexpr size_t OFF_W = 0;
constexpr size_t OFF_WQN = OFF_W + 2 * WL_BYTES;
constexpr size_t OFF_WOT = OFF_WQN + 2 * SLOT * 2;
constexpr size_t OFF_MEMN = OFF_WOT + 2 * SLOT * 2;
constexpr size_t OFF_WKV = OFF_MEMN + 2 * SLOT * 2;
constexpr size_t OFF_KVH = OFF_WKV + 4 * SLOT * 2;
constexpr size_t OFF_WQK = OFF_KVH + 64 * 65536 * 2;
constexpr size_t OFF_WVO = OFF_WQK + 8 * SLOT * 2;
constexpr size_t OFF_XB = OFF_WVO + 8 * SLOT * 2;
constexpr size_t OFF_ACT = OFF_XB + (size_t)MT * DM * 2;
constexpr size_t OFF_PROJ = OFF_ACT + (size_t)MT * FF * 2;
constexpr size_t OFF_SSQ = OFF_PROJ + (size_t)MT * INW * 2;
constexpr size_t OFF_QF = OFF_SSQ + (size_t)MT * 16 * 4;
constexpr size_t OFF_VTG = OFF_QF + (size_t)MT * 512 * 2;
constexpr size_t OFF_COS = OFF_VTG + (size_t)4 * 128 * SEQ * 2;
constexpr size_t OFF_SIN = OFF_COS + (size_t)MT * 32 * 4;
constexpr size_t OFF_CTL = OFF_SIN + (size_t)MT * 32 * 4;
constexpr size_t DO_P = 0, DO_MRG = (size_t)8 << 20;
__device__ __forceinline__ size_t drow(size_t r) { return ((r >> 12) << 23) + (r & 4095) * 1024; }
constexpr size_t CTL_BYTES = 32768;
constexpr size_t WS_END = OFF_CTL + CTL_BYTES;

constexpr int LDS_XCH = 131072;
constexpr int LDS_BARST = 131072 + 8192 + 512;
constexpr int LDS_RS = 131072 + 8192 + 1024;
constexpr int LDS_BYTES = LDS_RS + 12 * 1024;

__device__ __forceinline__ unsigned cvt_pk_bf16(float lo, float hi) { unsigned r; asm volatile("v_cvt_pk_bf16_f32 %0, %1, %2" : "=v"(r) : "v"(lo), "v"(hi)); return r; }
__device__ __forceinline__ u32x4 pair16(u32x2 we, u32x2 wo) {
    const auto a = __builtin_amdgcn_permlane32_swap(we.x, wo.x, false, false), b = __builtin_amdgcn_permlane32_swap(we.y, wo.y, false, false);
    u32x4 r; r.x = a[0]; r.y = b[0]; r.z = a[1]; r.w = b[1]; return r;
}
__device__ __forceinline__ float bf_lo(unsigned u) { return __uint_as_float(u << 16); }
__device__ __forceinline__ float bf_hi(unsigned u) { return __uint_as_float(u & 0xffff0000u); }
__device__ __forceinline__ float wave_sum(float v) {
#pragma unroll
    for (int o = 1; o < 64; o <<= 1) v += __shfl_xor(v, o);
    return v;
}
__device__ __forceinline__ float rs_of(f32x4 a) { return rsqrtf(((a.x + a.y) + (a.z + a.w)) * (1.0f / 1024.0f) + EPS); }
__device__ __forceinline__ float row_rs(const float* ssq, int row) {
    return rs_of(*(const f32x4*)(ssq + (size_t)row * 4));
}

constexpr int BM = 256, BK = 64, HALF = 128, HTB = HALF * BK * 2, NXCD = 8, WGM = 8;
__device__ __forceinline__ int lds_byte(int r, int c) { const int st = (r >> 4) * 2 + (c >> 5), rr = r & 15, cc = c & 31, ob = rr * 64 + cc * 2; return st * 1024 + (ob ^ (((ob >> 9) & 1) << 5)); }
__device__ __forceinline__ void stage_rc(int b, int& R, int& C) { const int st = b / 1024, sb = b % 1024, swz = sb ^ (((sb >> 9) & 1) << 5); R = (st >> 1) * 16 + swz / 64; C = (st & 1) * 32 + (swz % 64) / 2; }
__device__ __forceinline__ int perm32(int rho) { const int n = rho >> 4, i = rho & 15; return 8 * (i >> 2) + 4 * n + (i & 3); }

struct Unit { int pm, pn; };
struct Gemm { const bf16_t* A; const bf16_t* Bt; int lda, ldb, K, nM, nN, pm_div; size_t a_pm, a_b, a_pn, b_pn, b_b; int c_shift; int a_div; };
struct StaticOrder {
    int nM, nN, nwg, G, c;
    __device__ void init(int nM_, int nN_, int G_, int c_) { nM = nM_; nN = nN_; nwg = nM * nN; G = G_; c = c_; }
    __device__ bool next(int i, Unit& u) const {
        const long L = (long)i * G + c; if (L >= nwg) return false;
        int wgid = (int)L; { const int q = nwg / NXCD, r = nwg % NXCD, xcd = wgid % NXCD, off = wgid / NXCD; wgid = (xcd < r ? xcd * (q + 1) : r * (q + 1) + (xcd - r) * q) + off; }
        const int nig = WGM * nN, gid = wgid / nig, fm = gid * WGM, gsz = (nM - fm) < WGM ? (nM - fm) : WGM;
        u.pm = fm + ((wgid % nig) % gsz); u.pn = (wgid % nig) / gsz; return true;
    }
};

typedef f32x4 Acc[2][2][4][2];

struct EpiGateUp {
    static constexpr bool PERM = true, XCH = false, RS = true;
    const float* ssq; bf16_t* act;
    __device__ __forceinline__ void operator()(Acc& acc, const Unit& u, int ui, int wr, int wc, int fr, int fq, LAS unsigned char* lds) const {
        const LAS float* rsT = (const LAS float*)(lds + LDS_RS) + ui * 256 + wr * 64 + fr;
        const int row0 = u.pm * BM + wr * 64 + fr, col0 = u.pn * 128 + wc * 32 + 8 * fq;
#pragma unroll
        for (int ai = 0; ai < 2; ++ai)
#pragma unroll
            for (int m = 0; m < 4; ++m) {
                const int row = row0 + ai * HALF + m * 16; const float r = rsT[ai * HALF + m * 16];
                const float c1 = -r * LOG2E, r2 = r * r;
                float o[8];
#pragma unroll
                for (int n = 0; n < 2; ++n) { const f32x4 g = acc[ai][0][m][n], up = acc[ai][1][m][n]; const f32x4 t = g * c1;
                    f32x4 e; e.x = __builtin_amdgcn_exp2f(t.x); e.y = __builtin_amdgcn_exp2f(t.y); e.z = __builtin_amdgcn_exp2f(t.z); e.w = __builtin_amdgcn_exp2f(t.w);
                    const f32x4 d = e + 1.0f; f32x4 rc; rc.x = __builtin_amdgcn_rcpf(d.x); rc.y = __builtin_amdgcn_rcpf(d.y); rc.z = __builtin_amdgcn_rcpf(d.z); rc.w = __builtin_amdgcn_rcpf(d.w);
                    const f32x4 v = (g * up) * (rc * r2);
                    o[n * 4 + 0] = v.x; o[n * 4 + 1] = v.y; o[n * 4 + 2] = v.z; o[n * 4 + 3] = v.w; }
                u32x4 w; w.x = cvt_pk_bf16(o[0], o[1]); w.y = cvt_pk_bf16(o[2], o[3]); w.z = cvt_pk_bf16(o[4], o[5]); w.w = cvt_pk_bf16(o[6], o[7]);
                *(u32x4*)(act + (size_t)row * FF + col0) = w;
            }
    }
};
struct EpiResid {
    static constexpr bool PERM = true, XCH = false, RS = false;
    bf16_t* xb; float* ssq; float alpha;
    __device__ __forceinline__ void operator()(Acc& acc, const Unit& u, int ui, int wr, int wc, int fr, int fq, LAS unsigned char* lds) const {
        LAS float* X = (LAS float*)(lds + LDS_XCH);
        const int row0 = u.pm * BM + wr * 64 + fr, col0 = u.pn * BM + wc * 32 + 8 * fq;
#pragma unroll
        for (int ai = 0; ai < 2; ++ai)
#pragma unroll
            for (int m = 0; m < 4; ++m) {
                const int row = row0 + ai * HALF + m * 16; bf16_t* xr = xb + (size_t)row * DM + col0; float q = 0.f;
                const u32x4 x0 = *(const u32x4*)xr, x1 = *(const u32x4*)(xr + HALF);
#pragma unroll
                for (int bj = 0; bj < 2; ++bj) { const u32x4 xo = bj ? x1 : x0; float v[8];
#pragma unroll
                    for (int n = 0; n < 2; ++n) { const f32x4 a = acc[ai][bj][m][n] * alpha;
                        v[4 * n + 0] = bf_lo(xo[2 * n]) + a.x; v[4 * n + 1] = bf_hi(xo[2 * n]) + a.y; v[4 * n + 2] = bf_lo(xo[2 * n + 1]) + a.z; v[4 * n + 3] = bf_hi(xo[2 * n + 1]) + a.w; }
#pragma unroll
                    for (int j = 0; j < 8; ++j) q += v[j] * v[j];
                    u32x4 w; w.x = cvt_pk_bf16(v[0], v[1]); w.y = cvt_pk_bf16(v[2], v[3]); w.z = cvt_pk_bf16(v[4], v[5]); w.w = cvt_pk_bf16(v[6], v[7]);
                    *(u32x4*)(xr + bj * HALF) = w; }
                q += __shfl_xor(q, 16); q += __shfl_xor(q, 32);
                if (fq == 0) X[(ai * HALF + wr * 64 + m * 16 + fr) * 4 + wc] = q;
            }
        asm volatile("s_waitcnt lgkmcnt(0)" ::: "memory"); __builtin_amdgcn_s_barrier(); asm volatile("" ::: "memory");
        const int t = (wr * 4 + wc) * 64 + fq * 16 + fr;
        if (t < 256) { const f32x4 v = *(const LAS f32x4*)(X + t * 4); ssq[(size_t)(u.pm * BM + t) * 4 + u.pn] = (v.x + v.y) + (v.z + v.w); }
        asm volatile("s_waitcnt lgkmcnt(0)" ::: "memory");
    }
};
struct EpiWin {
    static constexpr bool PERM = true, XCH = false, RS = true;
    const float* ssq; const float* cs; const float* sn; bf16_t* proj; bf16_t* qf; bf16_t* vtg;
    __device__ __forceinline__ void operator()(Acc& acc, const Unit& u, int ui, int wr, int wc, int fr, int fq, LAS unsigned char* lds) const {
        const LAS float* rsT = (const LAS float*)(lds + LDS_RS) + ui * 256 + wr * 64 + fr;
        const int row0 = u.pm * BM + wr * 64 + fr, tile = u.pn;
        const bool rope = (tile < 2) || (tile == 2 && wc < 2);
#pragma unroll
        for (int ai = 0; ai < 2; ++ai)
#pragma unroll
            for (int m = 0; m < 4; ++m) {
                const int row = row0 + ai * HALF + m * 16; float r = rsT[ai * HALF + m * 16];
                bf16_t* prow = proj + (size_t)row * INW;
                float o0[8], o1[8]; int c0, c1;
                if (rope) {
                    if (tile < 2) r *= QSCALE_SWA;
                    const f32x4 ca = *(const f32x4*)(cs + (size_t)row * 32 + 8 * fq), cb = *(const f32x4*)(cs + (size_t)row * 32 + 8 * fq + 4);
                    const f32x4 sa = *(const f32x4*)(sn + (size_t)row * 32 + 8 * fq), sb = *(const f32x4*)(sn + (size_t)row * 32 + 8 * fq + 4);
#pragma unroll
                    for (int n = 0; n < 2; ++n)
#pragma unroll
                        for (int j = 0; j < 4; ++j) { const float x1 = acc[ai][0][m][n][j] * r, x2 = acc[ai][1][m][n][j] * r; const float c = n ? cb[j] : ca[j], s = n ? sb[j] : sa[j];
                            o0[n * 4 + j] = x1 * c - x2 * s; o1[n * 4 + j] = x2 * c + x1 * s; }
                    c0 = (tile < 2 ? tile * 256 : 512) + wc * 64 + 8 * fq; c1 = c0 + 32;
                } else {
#pragma unroll
                    for (int n = 0; n < 2; ++n)
#pragma unroll
                        for (int j = 0; j < 4; ++j) { o0[n * 4 + j] = acc[ai][0][m][n][j] * r; o1[n * 4 + j] = acc[ai][1][m][n][j] * r; }
                    if (tile == 2) { c0 = 640 + 32 * (wc - 2) + 8 * fq; c1 = c0 + 64; }
                    else { c0 = tile * 256 + wc * 32 + 8 * fq; c1 = c0 + 128; }
                }
                u32x4 w0, w1; w0.x = cvt_pk_bf16(o0[0], o0[1]); w0.y = cvt_pk_bf16(o0[2], o0[3]); w0.z = cvt_pk_bf16(o0[4], o0[5]); w0.w = cvt_pk_bf16(o0[6], o0[7]);
                w1.x = cvt_pk_bf16(o1[0], o1[1]); w1.y = cvt_pk_bf16(o1[2], o1[3]); w1.z = cvt_pk_bf16(o1[4], o1[5]); w1.w = cvt_pk_bf16(o1[6], o1[7]);
                if (tile < 2) {
                    bf16_t* qb = qf + ((((size_t)(row >> 5) * 8 + tile * 4 + wc) * 4 + (fq >> 1)) * 2 + (fq & 1)) * 256 + (size_t)(row & 31) * 8;
                    *(u32x4*)qb = w0; *(u32x4*)(qb + 2 * 2 * 256) = w1;
                } else if (tile == 2 && wc >= 2) {
                    bf16_t* vb = vtg + ((size_t)(row >> 13) * 128 + 32 * (wc - 2) + 8 * fq) * SEQ + (row & (SEQ - 1));
#pragma unroll
                    for (int e = 0; e < 4; ++e) { vb[(size_t)(2 * e) * SEQ] = (bf16_t)(w0[e] & 0xffffu); vb[(size_t)(2 * e + 1) * SEQ] = (bf16_t)(w0[e] >> 16);
                        vb[(size_t)(64 + 2 * e) * SEQ] = (bf16_t)(w1[e] & 0xffffu); vb[(size_t)(64 + 2 * e + 1) * SEQ] = (bf16_t)(w1[e] >> 16); }
                } else { *(u32x4*)(prow + c0) = w0; *(u32x4*)(prow + c1) = w1; }
            }
    }
};
struct EpiBf16 {
    static constexpr bool PERM = true, XCH = false, RS = false;
    bf16_t* out; size_t tb_pm, tb_pn; int ldc, mode; float scale;
    __device__ __forceinline__ void operator()(Acc& acc, const Unit& u, int ui, int wr, int wc, int fr, int fq, LAS unsigned char*) const {
        size_t tb = (size_t)u.pm * tb_pm + (size_t)u.pn * tb_pn;
        if (mode) tb = (size_t)((u.pn >> 2) * 32 + ((u.pm >> 2) * 4 + (u.pn & 3)) * 4 + (u.pm & 3)) * 65536;
        bf16_t* o = out + tb + (size_t)(wr * 64 + fr) * ldc + wc * 32 + 8 * fq;
#pragma unroll
        for (int ai = 0; ai < 2; ++ai)
#pragma unroll
            for (int m = 0; m < 4; ++m) {
#pragma unroll
                for (int bj = 0; bj < 2; ++bj) { const f32x4 v0 = acc[ai][bj][m][0] * scale, v1 = acc[ai][bj][m][1] * scale;
                    u32x4 w; w.x = cvt_pk_bf16(v0.x, v0.y); w.y = cvt_pk_bf16(v0.z, v0.w); w.z = cvt_pk_bf16(v1.x, v1.y); w.w = cvt_pk_bf16(v1.z, v1.w);
                    *(u32x4*)(o + (size_t)(ai * HALF + m * 16) * ldc + bj * HALF) = w; }
            }
    }
};
struct EpiSoftmax {
    static constexpr bool PERM = true, XCH = true, RS = true;
    const float* ssq; bf16_t* out; int ldc;
    __device__ __forceinline__ void operator()(Acc& acc, const Unit& u, int ui, int wr, int wc, int fr, int fq, LAS unsigned char* lds) const {
        const LAS float* rsT = (const LAS float*)(lds + LDS_RS) + ui * 256 + wr * 64 + fr;
        typedef float f32x2v __attribute__((ext_vector_type(2)));
        LAS f32x2v* X = (LAS f32x2v*)(lds + LDS_XCH);
        float mw[2][4];
#pragma unroll
        for (int ai = 0; ai < 2; ++ai)
#pragma unroll
            for (int m = 0; m < 4; ++m) {
                float mx = -3.0e38f; const float r = rsT[ai * HALF + m * 16];
#pragma unroll
                for (int bj = 0; bj < 2; ++bj)
#pragma unroll
                    for (int n = 0; n < 2; ++n) { const f32x4 v = acc[ai][bj][m][n] * r; acc[ai][bj][m][n] = v; mx = fmaxf(mx, fmaxf(fmaxf(v.x, v.y), fmaxf(v.z, v.w))); }
                mx = fmaxf(mx, __shfl_xor(mx, 16)); mx = fmaxf(mx, __shfl_xor(mx, 32));
                float s = 0.f;
#pragma unroll
                for (int bj = 0; bj < 2; ++bj)
#pragma unroll
                    for (int n = 0; n < 2; ++n) { f32x4 v = acc[ai][bj][m][n];
                        v.x = __builtin_amdgcn_exp2f(v.x - mx); v.y = __builtin_amdgcn_exp2f(v.y - mx); v.z = __builtin_amdgcn_exp2f(v.z - mx); v.w = __builtin_amdgcn_exp2f(v.w - mx);
                        s += (v.x + v.y) + (v.z + v.w); acc[ai][bj][m][n] = v; }
                s += __shfl_xor(s, 16); s += __shfl_xor(s, 32);
                mw[ai][m] = mx;
                if (fq == 0) X[(ai * HALF + wr * 64 + m * 16 + fr) * 4 + wc] = (f32x2v){mx, s};
            }
        asm volatile("s_waitcnt lgkmcnt(0)" ::: "memory"); __builtin_amdgcn_s_barrier(); asm volatile("" ::: "memory");
        const int row0 = u.pm * BM + wr * 64 + fr, col0 = u.pn * BM + wc * 32 + 8 * fq;
#pragma unroll
        for (int ai = 0; ai < 2; ++ai)
#pragma unroll
            for (int m = 0; m < 4; ++m) {
                const int rl = ai * HALF + wr * 64 + m * 16 + fr;
                const f32x2v a = X[rl * 4 + 0], b = X[rl * 4 + 1], c = X[rl * 4 + 2], d = X[rl * 4 + 3];
                const float M = fmaxf(fmaxf(a.x, b.x), fmaxf(c.x, d.x));
                const float L = (a.y * __builtin_amdgcn_exp2f(a.x - M) + b.y * __builtin_amdgcn_exp2f(b.x - M)) + (c.y * __builtin_amdgcn_exp2f(c.x - M) + d.y * __builtin_amdgcn_exp2f(d.x - M));
                const float f = __builtin_amdgcn_exp2f(mw[ai][m] - M) / L;
                const int row = row0 + ai * HALF + m * 16;
#pragma unroll
                for (int bj = 0; bj < 2; ++bj) { const f32x4 v0 = acc[ai][bj][m][0] * f, v1 = acc[ai][bj][m][1] * f;
                    u32x4 w; w.x = cvt_pk_bf16(v0.x, v0.y); w.y = cvt_pk_bf16(v0.z, v0.w); w.z = cvt_pk_bf16(v1.x, v1.y); w.w = cvt_pk_bf16(v1.z, v1.w);
                    *(u32x4*)(out + drow((size_t)row) + col0 + bj * HALF) = w; }
            }
        asm volatile("s_waitcnt lgkmcnt(0)" ::: "memory");
    }
};

template <class Epi>
__device__ __forceinline__ void gemm_phase(LAS unsigned char* lds, const Gemm g, const Epi& E) {
    constexpr bool ALIGN_EPI = true;
    int tid_ = threadIdx.x; asm volatile("" : "+v"(tid_));
    const int tid = tid_, wid = __builtin_amdgcn_readfirstlane(tid >> 6), lane = tid & 63, wr = wid >> 2, wc = wid & 3, fr = lane & 15, fq = lane >> 4;
    const int nt = g.K / BK;
    const unsigned vcu = ((volatile LAS unsigned*)(lds + LDS_BARST))[2];
    StaticOrder S; S.init(g.nM, g.nN, (int)gridDim.x, (int)((vcu + gridDim.x - (unsigned)g.c_shift % gridDim.x) % gridDim.x));
    unsigned voffA[2], voffB[2];
#pragma unroll
    for (int i = 0; i < 2; ++i) { int R, C; stage_rc(tid * 16 + i * 8192, R, C); const int Rb = Epi::PERM ? ((R & ~31) + perm32(R & 31)) : R;
        voffA[i] = (unsigned)(R * g.lda + C) * 2u; voffB[i] = (unsigned)(Rb * g.ldb + C) * 2u; }
    const size_t kstep = (size_t)(BK * 2);
    const size_t hstepA = (size_t)HALF * g.lda * 2, hstepB = (size_t)HALF * g.ldb * 2;
    const unsigned ldsw = (unsigned)wid * 1024u;
    const int aoff = lds_byte(wr * 64 + fr, fq * 8), boff = lds_byte(wc * 32 + fr, fq * 8);
#define G_ABASE(u) ((const char*)(g.A + (size_t)((u).pm % (g.a_div ? g.a_div : g.pm_div)) * g.a_pm + (size_t)((u).pm / (g.a_div ? g.a_div : g.pm_div)) * g.a_b + (size_t)(u).pn * g.a_pn))
#define G_BBASE(u) ((const char*)(g.Bt + (size_t)(u).pn * g.b_pn + (size_t)((u).pm / g.pm_div) * g.b_b))
#define PG8_SA(b, h) (((b) * 2 + (h)) * HTB)
#define PG8_SB(b, h) ((4 + (b) * 2 + (h)) * HTB)
#define PG8_STAGE(bufoff, gbase, voff) do { _Pragma("unroll") for (int _i = 0; _i < 2; ++_i) \
        __builtin_amdgcn_global_load_lds((const unsigned*)((const char*)(gbase) + (voff)[_i]), (LAS unsigned*)(lds + (bufoff) + ldsw + _i * 8192), 16, 0, 0); } while (0)
#define PG8_LDA(dst, b, h) do { _Pragma("unroll") for (int m = 0; m < 4; ++m) _Pragma("unroll") for (int k = 0; k < 2; ++k) dst[m][k] = *(const LAS bf16x8*)(lds + PG8_SA(b, h) + aoff + m * 2048 + k * 1024); } while (0)
#define PG8_LDB(dst, b, h) do { _Pragma("unroll") for (int n = 0; n < 2; ++n) _Pragma("unroll") for (int k = 0; k < 2; ++k) dst[n][k] = *(const LAS bf16x8*)(lds + PG8_SB(b, h) + boff + n * 2048 + k * 1024); } while (0)
#define PG8_MMA(ai, bj, At, Bt) do { __builtin_amdgcn_s_setprio(1); _Pragma("unroll") for (int m = 0; m < 4; ++m) _Pragma("unroll") for (int n = 0; n < 2; ++n) _Pragma("unroll") for (int k = 0; k < 2; ++k) \
        acc[ai][bj][m][n] = __builtin_amdgcn_mfma_f32_16x16x32_bf16(Bt[n][k], At[m][k], acc[ai][bj][m][n], 0, 0, 0); __builtin_amdgcn_s_setprio(0); } while (0)
#define PG8_WAIT_V(n) asm volatile("s_waitcnt vmcnt(" #n ")" ::: "memory")
#define PG8_WAIT_L(n) asm volatile("s_waitcnt lgkmcnt(" #n ")" ::: "memory")
#define PG8_BAR __builtin_amdgcn_s_barrier()
#define PG8_SCHED __builtin_amdgcn_sched_barrier(0)
    Unit cur, nxt; int ui = 0;
    if (!S.next(0, cur)) return;
    Acc acc;
#pragma unroll
    for (int a = 0; a < 2; ++a)
#pragma unroll
        for (int b = 0; b < 2; ++b)
#pragma unroll
            for (int m = 0; m < 4; ++m)
#pragma unroll
                for (int n = 0; n < 2; ++n) acc[a][b][m][n] = (f32x4){0.f, 0.f, 0.f, 0.f};
    bf16x8 At[4][2], B0[2][2], B1[2][2];
    const char* cA = G_ABASE(cur); const char* cB = G_BBASE(cur);
    PG8_STAGE(PG8_SB(0, 0), cB, voffB); PG8_STAGE(PG8_SB(0, 1), cB + hstepB, voffB); PG8_STAGE(PG8_SA(0, 0), cA, voffA); PG8_STAGE(PG8_SA(0, 1), cA + hstepA, voffA);
    if constexpr (Epi::RS) {
        f32x4 pv[6]; bool ok[6];
#pragma unroll
        for (int j = 0; j < 6; ++j) { Unit tu; ok[j] = S.next((tid >> 8) + 2 * j, tu); pv[j] = (f32x4){0.f, 0.f, 0.f, 0.f}; if (ok[j]) pv[j] = *(const f32x4*)(E.ssq + (size_t)(tu.pm * BM + (tid & 255)) * 4); }
#pragma unroll
        for (int j = 0; j < 6; ++j) if (ok[j]) ((LAS float*)(lds + LDS_RS))[((tid >> 8) + 2 * j) * 256 + (tid & 255)] = rs_of(pv[j]);
        asm volatile("s_waitcnt lgkmcnt(0)" ::: "memory"); __builtin_amdgcn_s_barrier(); asm volatile("" ::: "memory");
    }
    if (wr == 1) PG8_BAR;
    PG8_WAIT_V(2); PG8_BAR;
    PG8_STAGE(PG8_SB(1, 0), cB + kstep, voffB); PG8_STAGE(PG8_SA(1, 0), cA + kstep, voffA); PG8_STAGE(PG8_SB(1, 1), cB + hstepB + kstep, voffB);
    PG8_WAIT_V(6); PG8_BAR;
    for (;;) {
        const bool has_next = S.next(ui + 1, nxt);
        const char* nA = has_next ? G_ABASE(nxt) : cA; const char* nB = has_next ? G_BBASE(nxt) : cB;
        for (int t = 0; t < nt; t += 2) {
            const bool last = (t == nt - 2);
            const char* a1 = cA + (size_t)(t + 1) * kstep;
            const char* a2 = last ? nA : cA + (size_t)(t + 2) * kstep; const char* b2 = last ? nB : cB + (size_t)(t + 2) * kstep;
            const char* a3 = a2 + kstep; const char* b3 = b2 + kstep;
            PG8_LDB(B0, 0, 0); PG8_LDB(B1, 0, 1); PG8_SCHED; PG8_LDA(At, 0, 0); PG8_STAGE(PG8_SA(1, 1), a1 + hstepA, voffA);
            PG8_WAIT_V(8); PG8_WAIT_L(0); PG8_BAR; PG8_MMA(0, 0, At, B0); PG8_MMA(0, 1, At, B1); PG8_BAR; PG8_SCHED;
            PG8_LDA(At, 0, 1); PG8_STAGE(PG8_SB(0, 0), b2, voffB); PG8_STAGE(PG8_SB(0, 1), b2 + hstepB, voffB); PG8_STAGE(PG8_SA(0, 0), a2, voffA);
            PG8_WAIT_V(8); PG8_WAIT_L(0); PG8_BAR; PG8_MMA(1, 0, At, B0); PG8_MMA(1, 1, At, B1); PG8_BAR; PG8_SCHED;
            PG8_LDB(B0, 1, 0); PG8_LDB(B1, 1, 1); PG8_SCHED; PG8_LDA(At, 1, 0); PG8_STAGE(PG8_SA(0, 1), a2 + hstepA, voffA);
            PG8_WAIT_V(8); PG8_WAIT_L(0); PG8_BAR; PG8_MMA(0, 0, At, B0); PG8_MMA(0, 1, At, B1); PG8_BAR; PG8_SCHED;
            PG8_LDA(At, 1, 1); PG8_STAGE(PG8_SB(1, 0), b3, voffB); PG8_STAGE(PG8_SB(1, 1), b3 + hstepB, voffB); PG8_STAGE(PG8_SA(1, 0), a3, voffA);
            PG8_WAIT_V(8); PG8_WAIT_L(0); PG8_BAR; PG8_MMA(1, 0, At, B0); PG8_MMA(1, 1, At, B1); PG8_BAR; PG8_SCHED;
        }
        if constexpr (ALIGN_EPI) { if (wr == 0) PG8_BAR; }
        E(acc, cur, ui, wr, wc, fr, fq, lds);
        if (!has_next) break;
#pragma unroll
        for (int a = 0; a < 2; ++a)
#pragma unroll
            for (int b = 0; b < 2; ++b)
#pragma unroll
                for (int m = 0; m < 4; ++m)
#pragma unroll
                    for (int n = 0; n < 2; ++n) acc[a][b][m][n] = (f32x4){0.f, 0.f, 0.f, 0.f};
        cur = nxt; cA = nA; cB = nB; ++ui;
        if constexpr (ALIGN_EPI) { if (wr == 1) PG8_BAR; }
    }
    PG8_WAIT_V(0);
    if constexpr (!ALIGN_EPI) { if (wr == 0) PG8_BAR; }
    PG8_BAR;
#undef G_ABASE
#undef G_BBASE
#undef PG8_SA
#undef PG8_SB
#undef PG8_STAGE
#undef PG8_LDA
#undef PG8_LDB
#undef PG8_MMA
#undef PG8_WAIT_V
#undef PG8_WAIT_L
#undef PG8_BAR
#undef PG8_SCHED
}

enum { MAP_ID = 0, MAP_GATE = 1, MAP_UP = 2, MAP_WIN = 3 };
__device__ __forceinline__ int map_row(int kind, int n) {
    if (kind == MAP_GATE) return 256 * (n >> 7) + (n & 127);
    if (kind == MAP_UP) return 256 * (n >> 7) + 128 + (n & 127);
    if (kind == MAP_WIN) {
        if (n < 512) { const int head = n >> 6, d = n & 63, tile = head >> 2, hh = head & 3; return 256 * tile + (d < 32 ? 32 * hh + d : 128 + 32 * hh + d - 32); }
        if (n < 640) { const int kh = (n - 512) >> 6, d = n & 63; return 512 + (d < 32 ? 32 * kh + d : 128 + 32 * kh + d - 32); }
        if (n < 768) { const int vc = n - 640; return 512 + (vc < 64 ? 64 + vc : 128 + 64 + (vc - 64)); }
        return n;
    }
    return n;
}
__device__ __forceinline__ void conv_item(const float* W, const float* gain, int K, int N, bf16_t* WT, int kind, bool hm, LAS float* scr, int item, int lane) {
    const int nblk = N / 32, kb = item / nblk, nb = item % nblk, k0 = 64 * kb, n0 = 32 * nb;
    {
        const int kr = lane >> 3, c4 = lane & 7; f32x4 v[8]; float gv[8];
#pragma unroll
        for (int i = 0; i < 8; ++i) { v[i] = __builtin_nontemporal_load((const f32x4*)(W + (size_t)(k0 + 8 * i + kr) * N + n0 + 4 * c4));     gv[i] = gain ? gain[k0 + 8 * i + kr] : 1.0f; }
#pragma unroll
        for (int i = 0; i < 8; ++i) { LAS float* d = scr + (8 * i + kr) * 33 + 4 * c4; d[0] = v[i].x * gv[i]; d[1] = v[i].y * gv[i]; d[2] = v[i].z * gv[i]; d[3] = v[i].w * gv[i]; }
    }
    asm volatile("s_waitcnt lgkmcnt(0)" ::: "memory");
    const int c = lane & 7;
#pragma unroll
    for (int j = 0; j < 4; ++j) { const int n = (lane >> 3) + 8 * j; const LAS float* s = scr + (8 * c) * 33 + n;
        u32x4 o; o.x = cvt_pk_bf16(s[0 * 33], s[1 * 33]); o.y = cvt_pk_bf16(s[2 * 33], s[3 * 33]); o.z = cvt_pk_bf16(s[4 * 33], s[5 * 33]); o.w = cvt_pk_bf16(s[6 * 33], s[7 * 33]);
        const int kc = k0 + 8 * c; bf16_t* dp = hm ? WT + ((size_t)(kc >> 8) * N + n0 + n) * 256 + (kc & 255) : WT + (size_t)map_row(kind, n0 + n) * K + kc;
        *(u32x4*)dp = o; }
    asm volatile("s_waitcnt lgkmcnt(0)" ::: "memory");
}

struct Params { const float* in[25]; float* out; unsigned char* ws; int ph_lo, ph_hi; };

__device__ __forceinline__ void prologue(const Params& p, LAS unsigned char* lds) {
    int tid_ = threadIdx.x; asm volatile("" : "+v"(tid_));
    const int tid = tid_, lane = tid & 63, wave = __builtin_amdgcn_readfirstlane(tid >> 6);
    LAS float* scr = (LAS float*)(lds + wave * 16384);
    const int gw = blockIdx.x * 8 + wave, NGW = gridDim.x * 8;
    unsigned char* ws = p.ws;
    constexpr int IPL = 1408 * 6 + 640 + 512 * 2 + 1024 + 32;
    for (int it = gw; it < 2 * IPL; it += NGW) {
        const int l = it / IPL; int r = it % IPL; size_t wl_extra = 0;
        unsigned char* wl = ws + OFF_W + (size_t)l * WL_BYTES;
        int wi, gi = -1, K = 1024, N = 1024, kind = MAP_ID; size_t wstride = SLOT, doff; bool in_wl = true, hm = false;
        if (r < 1408) { wi = 4; gi = 3; N = FF; kind = MAP_GATE; wstride = (size_t)DM * FF; doff = WO_GU1; }
        else if ((r -= 1408) < 1408) { wi = 5; gi = 3; N = FF; kind = MAP_UP; wstride = (size_t)DM * FF; doff = WO_GU1; }
        else if ((r -= 1408) < 1408) { wi = 6; K = FF; wstride = (size_t)DM * FF; doff = WO_D1; }
        else if ((r -= 1408) < 640) { wi = 8; gi = 7; N = INW; kind = MAP_WIN; wstride = (size_t)DM * INW; doff = WO_IN; }
        else if ((r -= 640) < 512) { wi = 14; doff = WO_OUT; }
        else if ((r -= 512) < 1024) { wi = 18; N = 2048; wstride = 2 * SLOT; in_wl = false; doff = OFF_WKV + (size_t)l * 2 * SLOT * 2; }
        else if ((r -= 1024) < 512) { wi = 19; in_wl = false; hm = true; doff = OFF_WOT + (size_t)l * SLOT * 2; }
        else if ((r -= 512) < 1408) { wi = 21; gi = 20; N = FF; kind = MAP_GATE; wstride = (size_t)DM * FF; doff = WO_GU2; }
        else if ((r -= 1408) < 1408) { wi = 22; gi = 20; N = FF; kind = MAP_UP; wstride = (size_t)DM * FF; doff = WO_GU2; }
        else if ((r -= 1408) < 1408) { wi = 23; K = FF; wstride = (size_t)DM * FF; doff = WO_D2; }
        else { r -= 1408; const int g4 = r >> 3; r &= 7; wi = 10; K = 128; N = 128; wstride = 4 * 128 * 128; doff = WO_PW + (size_t)g4 * 128 * 128 * 2; wl_extra = (size_t)g4 * 128 * 128; }
        const float* W = (wi == 4 ? p.in[4] : wi == 5 ? p.in[5] : wi == 6 ? p.in[6] : wi == 8 ? p.in[8] : wi == 14 ? p.in[14] : wi == 18 ? p.in[18] : wi == 19 ? p.in[19] : wi == 21 ? p.in[21] : wi == 22 ? p.in[22] : wi == 23 ? p.in[23] : p.in[10]) + (size_t)l * wstride + wl_extra;
        const float* gain = gi < 0 ? nullptr : (gi == 3 ? p.in[3] : gi == 7 ? p.in[7] : p.in[20]) + l * DM;
        bf16_t* dst = (bf16_t*)((in_wl ? wl : ws) + doff);
        conv_item(W, gain, K, N, dst, kind, hm, scr, r, lane);
    }
    for (int it = gw; it < 2 * 1024; it += NGW) {
        const int l = it >> 10, row = it & 1023;
        const f32x4* xr = (const f32x4*)(p.in[1] + (size_t)row * DM) + lane; const f32x4* gr = (const f32x4*)(p.in[16] + l * DM) + lane;
        f32x4 v[4]; float s = 0.f;
#pragma unroll
        for (int j = 0; j < 4; ++j) { v[j] = xr[64 * j]; s += (v[j].x * v[j].x + v[j].y * v[j].y) + (v[j].z * v[j].z + v[j].w * v[j].w); }
        const float r = rsqrtf(wave_sum(s) * (1.0f / 1024.0f) + EPS);
        bf16_t* oa = (bf16_t*)(ws + OFF_MEMN) + (size_t)l * SLOT + (size_t)row * DM;
#pragma unroll
        for (int j = 0; j < 4; ++j) { const f32x4 g = gr[64 * j]; u32x2 w; w.x = cvt_pk_bf16(v[j].x * r * g.x, v[j].y * r * g.y); w.y = cvt_pk_bf16(v[j].z * r * g.z, v[j].w * r * g.w);
            *((u32x2*)oa + lane + 64 * j) = w; }
    }
    for (int it = gw; it < 2 * 1024; it += NGW) {
        const int l = it >> 10, k = it & 1023;
        const f32x4* xr = (const f32x4*)(p.in[17] + (size_t)l * SLOT + (size_t)k * DM) + lane; const float g = p.in[15][l * DM + k];
        bf16_t* o = (bf16_t*)(ws + OFF_WQN) + (size_t)l * SLOT + (size_t)k * 256;
#pragma unroll
        for (int j = 0; j < 4; ++j) { const f32x4 v = xr[64 * j]; u32x2 w; w.x = cvt_pk_bf16(v.x * g, v.y * g); w.y = cvt_pk_bf16(v.z * g, v.w * g);
            *((u32x2*)(o + (size_t)j * 1024 * 256) + lane) = w; }
    }
    for (int rb = gw * 4; rb < MT; rb += NGW * 4) {
        f32x4 v[4][4];
#pragma unroll
        for (int q = 0; q < 4; ++q) { const f32x4* xr = (const f32x4*)(p.in[0] + (size_t)(rb + q) * DM) + lane;
#pragma unroll
            for (int j = 0; j < 4; ++j) v[q][j] = __builtin_nontemporal_load(xr + 64 * j); }
#pragma unroll
        for (int q = 0; q < 4; ++q) { float s = 0.f;
#pragma unroll
            for (int j = 0; j < 4; ++j) s += (v[q][j].x * v[q][j].x + v[q][j].y * v[q][j].y) + (v[q][j].z * v[q][j].z + v[q][j].w * v[q][j].w);
            s = wave_sum(s);
            bf16_t* o = (bf16_t*)(ws + OFF_XB) + (size_t)(rb + q) * DM;
#pragma unroll
            for (int j = 0; j < 4; ++j) { u32x2 w; w.x = cvt_pk_bf16(v[q][j].x, v[q][j].y); w.y = cvt_pk_bf16(v[q][j].z, v[q][j].w); *((u32x2*)o + lane + 64 * j) = w; }
            if (lane < 4) ((float*)(ws + OFF_SSQ))[(size_t)(rb + q) * 4 + lane] = (lane == 0) ? s : 0.f; }
    }
    {
        const int* pos = (const int*)p.in[2]; float* cs = (float*)(ws + OFF_COS); float* sn = (float*)(ws + OFF_SIN);
        const int gt = blockIdx.x * 512 + tid, NGT = gridDim.x * 512;
        for (int i = gt; i < MT * 32; i += NGT) { const int row = i >> 5, f = i & 31;
            const float inv = powf(10000.0f, -(float)(2 * f) / 64.0f); const float ang = (float)pos[row] * inv;
            cs[i] = cosf(ang); sn[i] = sinf(ang); }
    }
}

constexpr int MX_KS = 0, MX_KSTR = 272, MX_VT = 160 * 272, MX_VSTR = 328, MX_XA = 86016, MX_XB = 87040;
constexpr int MX_US = 88064, MX_PL = 0, MX_PSTR = 1040;
static_assert(MX_VT + 128 * MX_VSTR <= MX_XA && MX_PL + 32 * MX_PSTR <= MX_VT && MX_US + 47 * 1024 <= LDS_BYTES, "mixer LDS map");
__device__ __forceinline__ int crow(int r, int hi) { return (r & 3) + 8 * (r >> 2) + 4 * hi; }

template <int W> __device__ __forceinline__ void pool_w(const LAS unsigned* U, LAS unsigned char* pl, int t0, int ts, int cp) {
    unsigned uu[16 + W - 1];
#pragma unroll
    for (int i = 0; i < 16 + W - 1; ++i) uu[i] = U[(ts + 15 - (W - 1) + i) * 256];
    float s0 = 0.f, s1 = 0.f;
#pragma unroll
    for (int i = 0; i < W - 1; ++i) { s0 += bf_lo(uu[i]); s1 += bf_hi(uu[i]); }
#pragma unroll
    for (int t = 0; t < 16; ++t) {
        const float c0 = bf_lo(uu[W - 1 + t]), c1 = bf_hi(uu[W - 1 + t]); s0 += c0; s1 += c1;
        const int tp = t0 + ts + t + 1; const float inv = (tp < W) ? 1.0f / (float)tp : 1.0f / (float)W;
        *(LAS unsigned*)(pl + (ts + t) * MX_PSTR + cp * 4) = cvt_pk_bf16(s0 * inv - c0, s1 * inv - c1);
        s0 -= bf_lo(uu[t]); s1 -= bf_hi(uu[t]);
    }
}
constexpr int MX_TAB = LDS_RS;
static_assert(MX_TAB + 3 * 2048 <= LDS_BYTES && MX_US + 47 * 1024 <= LDS_BARST && MX_TAB > LDS_BARST + 16, "mixer LDS map (tables)");

#define MX_BAR() do { asm volatile("s_waitcnt lgkmcnt(0)" ::: "memory"); __builtin_amdgcn_s_barrier(); asm volatile("" ::: "memory"); } while (0)
__device__ __forceinline__ void mixer_phase(LAS unsigned char* lds, const bf16_t* proj, const bf16_t* qfg, const bf16_t* vtg, bf16_t* mrg, const bf16_t* pwT, const float* sinks, const float* gA, const float* gB, const float* pscale) {
    int tid_ = threadIdx.x;
    {
        asm volatile("" : "+v"(tid_));
        LAS float* tab = (LAS float*)(lds + MX_TAB);
        tab[tid_] = gA[tid_]; tab[512 + tid_] = gB[tid_]; tab[1024 + tid_] = pscale[tid_];
    }
    const int vcu = (int)((volatile LAS unsigned*)(lds + LDS_BARST))[2];
    for (int unit0 = vcu; unit0 < MT / 32; unit0 += gridDim.x) {
        const int unit = (gridDim.x == 256) ? 128 * (vcu & 7) + (vcu >> 3) + 32 * (unit0 >> 8) : unit0;
        asm volatile("" : "+v"(tid_));
        const int tid = tid_, lane = tid & 63, wid = __builtin_amdgcn_readfirstlane(tid >> 6), r32 = lane & 31, hi = lane >> 5;
        const int b = unit >> 8, t0 = (unit & 255) * 32; const size_t row0 = (size_t)b * SEQ + t0;
#pragma unroll
        for (int i = 0; i < 5; ++i) { const int idx = tid + 512 * i, key = idx >> 4, ch = idx & 15; u32x4 v = (u32x4){0u, 0u, 0u, 0u};
            if (t0 - 128 + key >= 0) v = *(const u32x4*)(proj + (row0 - 128 + key) * INW + 512 + ch * 8);
            *(LAS u32x4*)(lds + MX_KS + key * MX_KSTR + ch * 16) = v; }
#pragma unroll
        for (int i = 0; i < 5; ++i) { const int idx = tid + 512 * i, chn = idx / 20, key0 = (idx % 20) * 8; u32x4 v = (u32x4){0u, 0u, 0u, 0u};
            if (t0 - 128 + key0 >= 0) v = *(const u32x4*)(vtg + ((size_t)b * 128 + chn) * SEQ + (t0 - 128 + key0));
            LAS u32x2* vt = (LAS u32x2*)(lds + MX_VT + chn * MX_VSTR + key0 * 2); vt[0] = (u32x2){v.x, v.y}; vt[1] = (u32x2){v.z, v.w}; }
#pragma unroll
        for (int i = 0; i < 6; ++i) { const int idx = tid + 512 * i; if (idx < 47 * 64) { const int lr = idx >> 6, ch = idx & 63; u32x4 v = (u32x4){0u, 0u, 0u, 0u};
                if (t0 + lr - 15 >= 0) v = *(const u32x4*)(proj + (row0 + lr - 15) * INW + 768 + ch * 8);
                *(LAS u32x4*)(lds + MX_US + lr * 1024 + ch * 16) = v; } }
        bf16x8 qf[4];
#pragma unroll
        for (int ks = 0; ks < 4; ++ks) qf[ks] = *(const bf16x8*)(qfg + ((((size_t)unit * 8 + wid) * 4 + ks) * 2 + hi) * 256 + r32 * 8);
        MX_BAR();
        const int kvh = wid >> 2;
        f32x16 s[5];
#pragma unroll
        for (int kt = 0; kt < 5; ++kt) {
            f32x16 a = (f32x16){0.f, 0.f, 0.f, 0.f, 0.f, 0.f, 0.f, 0.f, 0.f, 0.f, 0.f, 0.f, 0.f, 0.f, 0.f, 0.f};
#pragma unroll
            for (int ks = 0; ks < 4; ++ks) { const bf16x8 kf = *(const LAS bf16x8*)(lds + MX_KS + (32 * kt + r32) * MX_KSTR + (kvh * 64 + ks * 16 + hi * 8) * 2);
                a = __builtin_amdgcn_mfma_f32_32x32x16_bf16(kf, qf[ks], a, 0, 0, 0); }
            s[kt] = a;
        }
        const float sink2 = sinks[wid] * LOG2E;
        float mx = sink2;
        if (t0 >= 128) {
#pragma unroll
            for (int r = 0; r < 16; ++r) { const int k0 = crow(r, hi); if (k0 <= r32) s[0][r] = -1.0e30f; if (k0 > r32) s[4][r] = -1.0e30f; }
        } else {
#pragma unroll
            for (int kt = 0; kt < 5; ++kt)
#pragma unroll
                for (int r = 0; r < 16; ++r) { const int kk = 32 * kt + crow(r, hi); const int diff = (128 + r32) - kk;
                    const bool ok = (diff >= 0) && (diff < 128) && (t0 - 128 + kk >= 0); if (!ok) s[kt][r] = -1.0e30f; }
        }
#pragma unroll
        for (int kt = 0; kt < 5; ++kt)
#pragma unroll
            for (int r = 0; r < 16; ++r) mx = fmaxf(mx, s[kt][r]);
        mx = fmaxf(mx, __shfl_xor(mx, 32));
        float lsum = 0.f;
#pragma unroll
        for (int kt = 0; kt < 5; ++kt)
#pragma unroll
            for (int r = 0; r < 16; ++r) { const float e = __builtin_amdgcn_exp2f(s[kt][r] - mx); s[kt][r] = e; lsum += e; }
        lsum += __shfl_xor(lsum, 32); lsum += __builtin_amdgcn_exp2f(sink2 - mx);
        const float linv = 1.0f / lsum;
        f32x16 o[2];
#pragma unroll
        for (int dh = 0; dh < 2; ++dh) {
            f32x16 a = (f32x16){0.f, 0.f, 0.f, 0.f, 0.f, 0.f, 0.f, 0.f, 0.f, 0.f, 0.f, 0.f, 0.f, 0.f, 0.f, 0.f};
            const LAS unsigned char* vrow = lds + MX_VT + (kvh * 64 + 32 * dh + r32) * MX_VSTR;
#pragma unroll
            for (int kt = 0; kt < 5; ++kt)
#pragma unroll
                for (int st = 0; st < 2; ++st) {
                    const int key0 = 32 * kt + 16 * st + 4 * hi;
                    const u32x2 v0 = *(const LAS u32x2*)(vrow + key0 * 2), v1 = *(const LAS u32x2*)(vrow + (key0 + 8) * 2);
                    u32x4 av; av.x = v0.x; av.y = v0.y; av.z = v1.x; av.w = v1.y;
                    u32x4 pv; pv.x = cvt_pk_bf16(s[kt][8 * st + 0], s[kt][8 * st + 1]); pv.y = cvt_pk_bf16(s[kt][8 * st + 2], s[kt][8 * st + 3]);
                    pv.z = cvt_pk_bf16(s[kt][8 * st + 4], s[kt][8 * st + 5]); pv.w = cvt_pk_bf16(s[kt][8 * st + 6], s[kt][8 * st + 7]);
                    a = __builtin_amdgcn_mfma_f32_32x32x16_bf16(__builtin_bit_cast(bf16x8, av), __builtin_bit_cast(bf16x8, pv), a, 0, 0, 0);
                    if (st) __builtin_amdgcn_sched_barrier(0);
                }
            o[dh] = a;
        }
        float q2 = 0.f;
#pragma unroll
        for (int dh = 0; dh < 2; ++dh)
#pragma unroll
            for (int r = 0; r < 16; ++r) { const float v = o[dh][r] * linv; o[dh][r] = v; q2 += v * v; }
        q2 += __shfl_xor(q2, 32);
        if (hi == 0) ((LAS float*)(lds + MX_XA))[wid * 32 + r32] = q2;
        MX_BAR();
        {
            float tot = 0.f;
#pragma unroll
            for (int w = 0; w < 8; ++w) tot += ((LAS float*)(lds + MX_XA))[w * 32 + r32];
            const float rA = rsqrtf(tot * (1.0f / 512.0f) + EPS);
            bf16_t* orow = mrg + drow(row0 + r32) + wid * 64;
#pragma unroll
            for (int dh = 0; dh < 2; ++dh)
#pragma unroll
                for (int pq = 0; pq < 2; ++pq) { u32x2 w2[2];
#pragma unroll
                    for (int h2 = 0; h2 < 2; ++h2) { const int rq = 2 * pq + h2, d0 = 32 * dh + 8 * rq + 4 * hi; const f32x4 g = *(const LAS f32x4*)(lds + MX_TAB + (wid * 64 + d0) * 4);
                        w2[h2].x = cvt_pk_bf16(o[dh][4 * rq + 0] * rA * g.x, o[dh][4 * rq + 1] * rA * g.y); w2[h2].y = cvt_pk_bf16(o[dh][4 * rq + 2] * rA * g.z, o[dh][4 * rq + 3] * rA * g.w); }
                    *(u32x4*)(orow + 32 * dh + 16 * pq + 8 * hi) = pair16(w2[0], w2[1]); }
        }
        bf16x8 wf[2][8];
#pragma unroll
        for (int e = 0; e < 2; ++e)
#pragma unroll
            for (int ks = 0; ks < 8; ++ks) wf[e][ks] = *(const bf16x8*)(pwT + ((size_t)((wid >> 1) * 128 + 32 * (2 * (wid & 1) + e) + r32)) * 128 + hi * 8 + ks * 16);
        {
            const int cp = tid & 255, ts = 16 * (tid >> 8), gsel = __builtin_amdgcn_readfirstlane(cp >> 6);
            const LAS unsigned* U = (const LAS unsigned*)(lds + MX_US) + cp;
            if (gsel == 0) pool_w<2>(U, lds + MX_PL, t0, ts, cp); else if (gsel == 1) pool_w<4>(U, lds + MX_PL, t0, ts, cp);
            else if (gsel == 2) pool_w<8>(U, lds + MX_PL, t0, ts, cp); else pool_w<16>(U, lds + MX_PL, t0, ts, cp);
        }
        MX_BAR();
        {
            const int g = wid >> 1, nh = wid & 1;
            f32x16 acc2[2];
#pragma unroll
            for (int e = 0; e < 2; ++e) {
                f32x16 a = (f32x16){0.f, 0.f, 0.f, 0.f, 0.f, 0.f, 0.f, 0.f, 0.f, 0.f, 0.f, 0.f, 0.f, 0.f, 0.f, 0.f};
#pragma unroll
                for (int ks = 0; ks < 8; ++ks) { const bf16x8 af = wf[e][ks];
                    const bf16x8 bfr = *(const LAS bf16x8*)(lds + MX_PL + r32 * MX_PSTR + (g * 128 + ks * 16 + hi * 8) * 2);
                    a = __builtin_amdgcn_mfma_f32_32x32x16_bf16(af, bfr, a, 0, 0, 0); }
                acc2[e] = a;
            }
            float q3 = 0.f;
#pragma unroll
            for (int e = 0; e < 2; ++e)
#pragma unroll
                for (int rq = 0; rq < 4; ++rq) { const int ch = g * 128 + 32 * (2 * nh + e) + 8 * rq + 4 * hi; const f32x4 sc = *(const LAS f32x4*)(lds + MX_TAB + (1024 + ch) * 4);
#pragma unroll
                    for (int j = 0; j < 4; ++j) { const float v = acc2[e][4 * rq + j] * sc[j]; acc2[e][4 * rq + j] = v; q3 += v * v; } }
            q3 += __shfl_xor(q3, 32);
            if (hi == 0) ((LAS float*)(lds + MX_XB))[wid * 32 + r32] = q3;
            MX_BAR();
            float tot = 0.f;
#pragma unroll
            for (int w = 0; w < 8; ++w) tot += ((LAS float*)(lds + MX_XB))[w * 32 + r32];
            const float rB = rsqrtf(tot * (1.0f / 512.0f) + EPS);
            bf16_t* orow = mrg + drow(row0 + r32) + 512;
#pragma unroll
            for (int e = 0; e < 2; ++e)
#pragma unroll
                for (int pq = 0; pq < 2; ++pq) { u32x2 w2[2];
#pragma unroll
                    for (int h2 = 0; h2 < 2; ++h2) { const int rq = 2 * pq + h2, ch = g * 128 + 32 * (2 * nh + e) + 8 * rq + 4 * hi; const f32x4 gg = *(const LAS f32x4*)(lds + MX_TAB + (512 + ch) * 4);
                        w2[h2].x = cvt_pk_bf16(acc2[e][4 * rq + 0] * rB * gg.x, acc2[e][4 * rq + 1] * rB * gg.y); w2[h2].y = cvt_pk_bf16(acc2[e][4 * rq + 2] * rB * gg.z, acc2[e][4 * rq + 3] * rB * gg.w); }
                    *(u32x4*)(orow + g * 128 + 32 * (2 * nh + e) + 16 * pq + 8 * hi) = pair16(w2[0], w2[1]); }
        }
    }
}

#define XB_TMO      128
#define XB_XCNT(j)  (256  + 64 * (j))
#define XB_XSUB(j)  (1280 + 64 * (j))
#define XB_XGEN(j)  (2304 + 64 * (j))
#define XB_TOP      3328
#define XB_TOPGEN   3392
#define XCD_BAR_WORDS 3456
#define XB_SPIN_CAP (1u << 18)

__device__ __forceinline__ unsigned xb_ld(unsigned* p)              { return __hip_atomic_load(p, __ATOMIC_RELAXED, __HIP_MEMORY_SCOPE_AGENT); }
__device__ __forceinline__ unsigned xb_add(unsigned* p, unsigned v) { return __hip_atomic_fetch_add(p, v, __ATOMIC_RELAXED, __HIP_MEMORY_SCOPE_AGENT); }
__device__ __forceinline__ unsigned xb_xcc_id() { return (unsigned)__builtin_amdgcn_s_getreg((3 << 11) | 20) & 0xFu; }
#define XB_SPIN(cond, bar) do { unsigned _sp = 0; while (cond) { __builtin_amdgcn_s_sleep(1); \
    if ((++_sp & 255u) == 0u) { if (xb_ld(&(bar)[XB_TMO])) break; if (_sp > XB_SPIN_CAP) { atomicAdd(&(bar)[XB_TMO], 1u); break; } } } } while (0)

struct XcdBarrier {
    unsigned* bar; unsigned x;
    volatile LAS unsigned* st;
};

__device__ __forceinline__ XcdBarrier xcd_barrier_post(unsigned* bar, volatile LAS unsigned* st) {
    XcdBarrier b; b.bar = bar; b.x = xb_xcc_id(); b.st = st;
    if (threadIdx.x == 0) (void)xb_add(&bar[XB_XCNT(b.x)], 1u);
    return b;
}
__device__ __forceinline__ void xcd_barrier_complete(unsigned* bar, unsigned x, unsigned& nloc, unsigned& nx) {
    const unsigned G = gridDim.x * gridDim.y * gridDim.z;
    unsigned sum, cnt, mine, sp = 0u;
    for (;;) {
        sum = 0u; cnt = 0u; mine = 0u;
#pragma unroll
        for (unsigned j = 0; j < 16; ++j) { const unsigned c = xb_ld(&bar[XB_XCNT(j)]); sum += c; cnt += (c > 0u) ? 1u : 0u; mine = (j == x) ? c : mine; }
        if (sum == G) break;
        __builtin_amdgcn_s_sleep(1);
        if ((++sp & 255u) == 0u) { if (xb_ld(&bar[XB_TMO])) break; if (sp > XB_SPIN_CAP) { atomicAdd(&bar[XB_TMO], 1u); break; } }
    }
    nloc = mine > 0u ? mine : 1u; nx = cnt > 0u ? cnt : 1u;
}

__device__ __forceinline__ void xcd_barrier(const XcdBarrier& b) {
    asm volatile("s_waitcnt vmcnt(0)" ::: "memory");
    __syncthreads();
    if (threadIdx.x == 0) {
        unsigned* bar = b.bar;
        __builtin_amdgcn_s_waitcnt(0);
        unsigned nloc = b.st[0], nx = b.st[1];
        if (nloc == 0u) { xcd_barrier_complete(bar, b.x, nloc, nx); b.st[0] = nloc; b.st[1] = nx; }
        const unsigned old = xb_add(&bar[XB_XSUB(b.x)], 1u);
        const unsigned gen = old / nloc;
        if (old + 1u == (gen + 1u) * nloc) {
            __builtin_amdgcn_fence(__ATOMIC_RELEASE, "agent");
            asm volatile("s_waitcnt vmcnt(0)" ::: "memory");
            const unsigned og = xb_add(&bar[XB_TOP], 1u);
            const unsigned tg = og / nx;
            if (og + 1u == (tg + 1u) * nx) xb_add(&bar[XB_TOPGEN], 1u);
            else XB_SPIN(xb_ld(&bar[XB_TOPGEN]) == tg, bar);
            __builtin_amdgcn_fence(__ATOMIC_ACQUIRE, "agent");
            xb_add(&bar[XB_XGEN(b.x)], 1u);
            asm volatile("s_waitcnt vmcnt(0)" ::: "memory");
        } else {
            XB_SPIN(xb_ld(&bar[XB_XGEN(b.x)]) == gen, bar);
            __builtin_amdgcn_fence(__ATOMIC_ACQUIRE, "agent");
            asm volatile("s_waitcnt vmcnt(0)" ::: "memory");
        }
    }
    __syncthreads();
}

#define XL_SUB(j)   (3456 + 64 * (j))
#define XL_GEN(j)   (3456 + 1024 + 64 * (j))
__device__ __forceinline__ void xcd_local_barrier(unsigned* bar, unsigned x, unsigned nloc) {
    asm volatile("s_waitcnt vmcnt(0)" ::: "memory");
    __syncthreads();
    if (threadIdx.x == 0) {
        __builtin_amdgcn_s_waitcnt(0);
        const unsigned old = xb_add(&bar[XL_SUB(x)], 1u);
        const unsigned gen = old / nloc;
        if (old + 1u == (gen + 1u) * nloc) xb_add(&bar[XL_GEN(x)], 1u);
        else XB_SPIN(xb_ld(&bar[XL_GEN(x)]) == gen, bar);
        __builtin_amdgcn_fence(__ATOMIC_ACQUIRE, "agent");
        asm volatile("s_waitcnt vmcnt(0)" ::: "memory");
    }
    __syncthreads();
}

constexpr int N_HEAD = 1, N_SUB = 9, N_PHASES = N_HEAD + 2 * N_SUB + 1;
__global__ void __launch_bounds__(512) hymba_fwd(Params p) {
    extern __shared__ __attribute__((aligned(16))) unsigned char lds_raw[];
    LAS unsigned char* lds = (LAS unsigned char*)lds_raw;
    unsigned char* ws = p.ws;
    bf16_t* XB = (bf16_t*)(ws + OFF_XB); bf16_t* ACT = (bf16_t*)(ws + OFF_ACT); bf16_t* PROJ = (bf16_t*)(ws + OFF_PROJ); bf16_t* MRG = (bf16_t*)((unsigned char*)p.out + DO_MRG); bf16_t* PB = (bf16_t*)((unsigned char*)p.out + DO_P);
    float* SSQ = (float*)(ws + OFF_SSQ);
    const size_t BIG = (size_t)256 * 1024;
    volatile LAS unsigned* MISCW = (volatile LAS unsigned*)(lds + LDS_BARST);
    if (threadIdx.x < 8) MISCW[threadIdx.x] = (threadIdx.x == 2) ? blockIdx.x : 0u;
    __syncthreads();
    if (threadIdx.x == 0) { const unsigned x_ = xb_xcc_id(); MISCW[5] = x_; MISCW[4] = xb_add(&((unsigned*)(ws + OFF_CTL))[XB_XCNT(x_)], 1u); }
    if (p.ph_lo <= 0 && 0 < p.ph_hi) { for (int rep = 0; rep <= PROBE_PRO; ++rep) { if (rep) GSYNC(); prologue(p, lds); __syncthreads(); } }
    bool synced = false;
    if (p.ph_lo == 0 && p.ph_hi > 1) {
        GSYNC(); synced = true;
        if (threadIdx.x == 0) {
            unsigned* bar = (unsigned*)(ws + OFF_CTL); bool ok = (gridDim.x == 256);
            for (unsigned j = 0; j < 16; ++j) { const unsigned c = xb_ld(&bar[XB_XCNT(j)]); ok = ok && (c == (j < 8 ? 32u : 0u)); }
            if (ok && MISCW[4] < 32u && MISCW[5] < 8u) { MISCW[2] = MISCW[4] * 8u + MISCW[5]; MISCW[3] = 1u; }
        }
        __syncthreads();
    }
    const int ph_a = p.ph_lo > N_HEAD ? p.ph_lo : N_HEAD, ph_b = p.ph_hi < N_PHASES - 1 ? p.ph_hi : N_PHASES - 1;
    for (int ph = ph_a; ph < ph_b; ++ph) {
        const int l = (ph - N_HEAD) / N_SUB, sp = (ph - N_HEAD) % N_SUB;
        for (int rep = 0; rep <= ((PROBE_MASK >> sp) & 1); ++rep) {
        if (rep || (ph > p.ph_lo && !(synced && ph == N_HEAD))) SEAM(!rep && !(l == 0 && sp == 0) && sp != 3 && !(sp == 4 && l == 0));
        unsigned char* wl = ws + OFF_W + (size_t)l * WL_BYTES;
        if (sp == 0 || sp == 7) {
            Gemm g{XB, (const bf16_t*)(wl + (sp == 0 ? WO_GU1 : WO_GU2)), 1024, 1024, 1024, 128, 22, 1 << 30, BIG, 0, 0, BIG, 0, 0};
            EpiGateUp E{SSQ, ACT};
            gemm_phase<EpiGateUp>(lds, g, E);
        } else if (sp == 1 || sp == 8 || sp == 4 || sp == 6) {
            Gemm g;
            if (sp == 1 || sp == 8) g = Gemm{ACT, (const bf16_t*)(wl + (sp == 1 ? WO_D1 : WO_D2)), FF, FF, FF, 128, 4, 1 << 30, (size_t)256 * FF, 0, 0, (size_t)256 * FF, 0, 0};
            else if (sp == 4) g = Gemm{MRG, (const bf16_t*)(wl + WO_OUT), 1024, 1024, 1024, 128, 4, 1 << 30, BIG, (size_t)1 << 23, 0, BIG, 0, 0, 16};
            else g = Gemm{PB, (const bf16_t*)(ws + OFF_WVO) + (size_t)l * 4 * SLOT, 1024, 1024, 1024, 128, 4, 32, BIG, (size_t)1 << 23, 0, BIG, SLOT, 0, 16};
            EpiResid E{XB, SSQ, (sp == 1 || sp == 8) ? 0.5f : 1.0f};
            gemm_phase<EpiResid>(lds, g, E);
        } else if (sp == 2) {
            Gemm g{XB, (const bf16_t*)(wl + WO_IN), 1024, 1024, 1024, 128, 5, 1 << 30, BIG, 0, 0, BIG, 0, 0};
            EpiWin E{SSQ, (const float*)(ws + OFF_COS), (const float*)(ws + OFF_SIN), PROJ, (bf16_t*)(ws + OFF_QF), (bf16_t*)(ws + OFF_VTG)};
            gemm_phase<EpiWin>(lds, g, E);
        } else if (sp == 3) {
            mixer_phase(lds, PROJ, (const bf16_t*)(ws + OFF_QF), (const bf16_t*)(ws + OFF_VTG), MRG, (const bf16_t*)(wl + WO_PW), p.in[9] + l * 8, p.in[12] + l * 512, p.in[13] + l * 512, p.in[11] + l * 512);
        } else if (sp == 5) {
            Gemm g{XB, (const bf16_t*)(ws + OFF_WQK) + (size_t)l * 4 * SLOT, 1024, 1024, 1024, 128, 4, 32, BIG, 32 * BIG, 0, BIG, SLOT, 0};
            EpiSoftmax E{SSQ, PB, 1024};
            gemm_phase<EpiSoftmax>(lds, g, E);
        }
        const int nbf = (l == 0 && rep == 0) ? (sp == 2 ? 1 : sp == 3 ? 16 : 0) : 0;
        for (int i = 0; i < nbf; ++i) {
            Gemm g; EpiBf16 E;
            if (sp == 2) {
                g = Gemm{(const bf16_t*)(ws + OFF_MEMN), (const bf16_t*)(ws + OFF_WKV), 1024, 1024, 1024, 8, 8, 4, BIG, 4 * BIG, 0, BIG, 2 * SLOT, 128};
                E = EpiBf16{(bf16_t*)(ws + OFF_KVH), 0, 0, 256, 1, 1.0f};
            } else {
                const int lh = i & 7, l2 = lh >> 2, h = lh & 3;
                if (i < 8) {
                    g = Gemm{(const bf16_t*)(ws + OFF_KVH) + (size_t)(lh * 4) * 65536, (const bf16_t*)(ws + OFF_WQN) + (size_t)lh * 262144, 256, 256, 256, 4, 4, 1 << 30, 65536, 0, 0, 65536, 0, 16 * i};
                    E = EpiBf16{(bf16_t*)(ws + OFF_WQK) + (size_t)l2 * 4 * SLOT + (size_t)h * 256 * 1024, SLOT, 256, 1024, 0, QSCALE_X};
                } else {
                    g = Gemm{(const bf16_t*)(ws + OFF_WOT) + (size_t)lh * 262144, (const bf16_t*)(ws + OFF_KVH) + (size_t)(32 + lh * 4) * 65536, 256, 256, 256, 4, 4, 1 << 30, 65536, 0, 0, 65536, 0, 16 * i};
                    E = EpiBf16{(bf16_t*)(ws + OFF_WVO) + (size_t)l2 * 4 * SLOT + (size_t)h * 256, BIG, SLOT, 1024, 0, 1.0f};
                }
            }
            gemm_phase<EpiBf16>(lds, g, E);
        }
        }
    }
    if (p.ph_lo <= N_PHASES - 1 && N_PHASES - 1 < p.ph_hi) {
        if (N_PHASES - 1 > p.ph_lo) SEAM(true);
        int tid_ = threadIdx.x; asm volatile("" : "+v"(tid_));
        const int vcu = (int)MISCW[2]; const int lane = tid_ & 63, gw = vcu * 8 + (tid_ >> 6), NGW = gridDim.x * 8;
        for (int row0 = gw; row0 < MT; row0 += NGW) {
            const int k_ = row0 / NGW;
            const int row = (gridDim.x == 256) ? 4096 * (vcu & 7) + 128 * (vcu >> 3) + 16 * (tid_ >> 6) + k_ : row0;
            const float r = row_rs(SSQ, row); const u32x2* xr = (const u32x2*)(XB + (size_t)row * DM) + lane; f32x4* orow = (f32x4*)(p.out + (size_t)row * DM) + lane; const f32x4* gr = (const f32x4*)p.in[24] + lane;
#pragma unroll
            for (int j = 0; j < 4; ++j) { const u32x2 v = xr[64 * j]; const f32x4 g = gr[64 * j]; __builtin_nontemporal_store((f32x4){bf_lo(v.x) * r * g.x, bf_hi(v.x) * r * g.y, bf_lo(v.y) * r * g.z, bf_hi(v.y) * r * g.w}, orow + 64 * j); }
        }
    }
}

extern "C" void kernel_launch(void* const* d_in, const int* in_sizes, int n_in, void* d_out, int out_size, void* d_ws, size_t ws_size, hipStream_t stream) {
    static int grid = 0;
    if (grid == 0) {
        if (n_in != 25 || out_size != MT * DM || ws_size < WS_END) { fprintf(stderr, "kernel_launch: unexpected shapes (n_in %d out %d ws %zu need %zu)\n", n_in, out_size, ws_size, (size_t)WS_END); grid = -1; return; }
        int dev = 0, cus = 0, per_cu = 0;
        hipGetDevice(&dev); hipDeviceGetAttribute(&cus, hipDeviceAttributeMultiprocessorCount, dev);
        if (hipFuncSetAttribute((const void*)hymba_fwd, hipFuncAttributeMaxDynamicSharedMemorySize, LDS_BYTES) != hipSuccess) { fprintf(stderr, "kernel_launch: hipFuncSetAttribute failed\n"); grid = -1; return; }
        if (hipOccupancyMaxActiveBlocksPerMultiprocessor(&per_cu, (const void*)hymba_fwd, 512, LDS_BYTES) != hipSuccess || per_cu < 1) { fprintf(stderr, "kernel_launch: occupancy query gave %d\n", per_cu); per_cu = 1; }
        (void)hipGetLastError();
        grid = cus;
    }
    if (grid < 0) return;
    Params p{};
    for (int i = 0; i < 25; ++i) p.in[i] = (const float*)d_in[i];
    p.out = (float*)d_out; p.ws = (unsigned char*)d_ws;
#if MK_ONE_LAUNCH
    p.ph_lo = 0; p.ph_hi = N_PHASES;
    if (hipMemsetAsync((char*)d_ws + OFF_CTL, 0, CTL_BYTES, stream) != hipSuccess) { fprintf(stderr, "kernel_launch: memset of the barrier words failed\n"); return; }
    void* args[] = {&p};
    hipError_t e = hipLaunchCooperativeKernel((const void*)hymba_fwd, dim3(grid), dim3(512), args, LDS_BYTES, stream);
    if (e != hipSuccess) fprintf(stderr, "cooperative launch failed: %s (grid %d)\n", hipGetErrorString(e), grid);
#else
    for (int ph = 0; ph < N_PHASES; ++ph) { p.ph_lo = ph; p.ph_hi = ph + 1; hipLaunchKernelGGL(hymba_fwd, dim3(grid), dim3(512), LDS_BYTES, stream, p); }
#endif
}
```

```cpp
#include <hip/hip_runtime.h>
#include <hip/hip_cooperative_groups.h>
#include <cstdio>
#include <cstdint>
namespace cg = cooperative_groups;

#ifndef MK_ONE_LAUNCH
#define MK_ONE_LAUNCH 1
#endif
#ifndef PROBE_MASK
#define PROBE_MASK 0
#endif
#ifndef PROBE_PRO
#define PROBE_PRO 0
#endif
#ifndef PROBE_NSYNC
#define PROBE_NSYNC 1
#endif
#define SEAM(local_ok_) do { if ((local_ok_) && MISCW[3]) { unsigned char* wq2_ = p.ws; asm volatile("" : "+v"(wq2_)); xcd_local_barrier((unsigned*)(wq2_ + OFF_CTL), MISCW[5], 32u); } else GSYNC(); } while (0)
#define GSYNC() do { for (int s_ = 0; s_ < PROBE_NSYNC; ++s_) { if (p.ph_hi > 4096) cg::this_grid().sync(); else { XcdBarrier gb_; { unsigned char* wq_ = p.ws; asm volatile("" : "+v"(wq_)); gb_.bar = (unsigned*)(wq_ + OFF_CTL); } gb_.x = xb_xcc_id(); gb_.st = (volatile LAS unsigned*)(lds + LDS_BARST); xcd_barrier(gb_); } } } while (0)

#define LAS __attribute__((address_space(3)))
typedef unsigned short bf16_t;
typedef short bf16x8 __attribute__((ext_vector_type(8)));
typedef float f32x4 __attribute__((ext_vector_type(4)));
typedef float f32x16 __attribute__((ext_vector_type(16)));
typedef unsigned u32x4 __attribute__((ext_vector_type(4)));
typedef unsigned u32x2 __attribute__((ext_vector_type(2)));

constexpr int MT = 32768;
constexpr int SEQ = 8192;
constexpr int DM = 1024;
constexpr int FF = 2816;
constexpr int INW = 1280;
constexpr float EPS = 1e-6f;
constexpr float LOG2E = 1.4426950408889634f;
constexpr float QSCALE_SWA = 0.125f * LOG2E;
constexpr float QSCALE_X = 0.0625f * LOG2E;

constexpr size_t SLOT = 1024 * 1024;
constexpr size_t WO_GU1 = 0;
constexpr size_t WO_D1 = WO_GU1 + (size_t)5632 * 1024 * 2;
constexpr size_t WO_IN = WO_D1 + (size_t)1024 * 2816 * 2;
constexpr size_t WO_OUT = WO_IN + (size_t)1280 * 1024 * 2;
constexpr size_t WO_GU2 = WO_OUT + SLOT * 2;
constexpr size_t WO_D2 = WO_GU2 + (size_t)5632 * 1024 * 2;
constexpr size_t WO_PW = WO_D2 + (size_t)1024 * 2816 * 2;
constexpr size_t WL_BYTES = WO_PW + 4 * 128 * 128 * 2;
constexpr size_t OFF_W = 0;
constexpr size_t OFF_WQN = OFF_W + 2 * WL_BYTES;
constexpr size_t OFF_WOT = OFF_WQN + 2 * SLOT * 2;
constexpr size_t OFF_MEMN = OFF_WOT + 2 * SLOT * 2;
constexpr size_t OFF_WKV = OFF_MEMN + 2 * SLOT * 2;
constexpr size_t OFF_KVH = OFF_WKV + 4 * SLOT * 2;
constexpr size_t OFF_WQK = OFF_KVH + 64 * 65536 * 2;
constexpr size_t OFF_WVO = OFF_WQK + 8 * SLOT * 2;
constexpr size_t OFF_XB = OFF_WVO + 8 * SLOT * 2;
constexpr size_t OFF_ACT = OFF_XB + (size_t)MT * DM * 2;
constexpr size_t OFF_PROJ = OFF_ACT + (size_t)MT * FF * 2;
constexpr size_t OFF_SSQ = OFF_PROJ + (size_t)MT * INW * 2;
constexpr size_t OFF_QF = OFF_SSQ + (size_t)MT * 16 * 4;
constexpr size_t OFF_VTG = OFF_QF + (size_t)MT * 512 * 2;
constexpr size_t OFF_COS = OFF_VTG + (size_t)4 * 128 * SEQ * 2;
constexpr size_t OFF_SIN = OFF_COS + (size_t)MT * 32 * 4;
constexpr size_t OFF_CTL = OFF_SIN + (size_t)MT * 32 * 4;
constexpr size_t DO_P = 0, DO_MRG = (size_t)8 << 20;
__device__ __forceinline__ size_t drow(size_t r) { return ((r >> 12) << 23) + (r & 4095) * 1024; }
constexpr size_t CTL_BYTES = 32768;
constexpr size_t WS_END = OFF_CTL + CTL_BYTES;

constexpr int LDS_XCH = 131072;
constexpr int LDS_BARST = 131072 + 8192 + 512;
constexpr int LDS_RS = 131072 + 8192 + 1024;
constexpr int LDS_BYTES = LDS_RS + 12 * 1024;

__device__ __forceinline__ unsigned cvt_pk_bf16(float lo, float hi) { unsigned r; asm volatile("v_cvt_pk_bf16_f32 %0, %1, %2" : "=v"(r) : "v"(lo), "v"(hi)); return r; }
__device__ __forceinline__ u32x4 pair16(u32x2 we, u32x2 wo) {
    const auto a = __builtin_amdgcn_permlane32_swap(we.x, wo.x, false, false), b = __builtin_amdgcn_permlane32_swap(we.y, wo.y, false, false);
    u32x4 r; r.x = a[0]; r.y = b[0]; r.z = a[1]; r.w = b[1]; return r;
}
__device__ __forceinline__ float bf_lo(unsigned u) { return __uint_as_float(u << 16); }
__device__ __forceinline__ float bf_hi(unsigned u) { return __uint_as_float(u & 0xffff0000u); }
__device__ __forceinline__ float wave_sum(float v) {
#pragma unroll
    for (int o = 1; o < 64; o <<= 1) v += __shfl_xor(v, o);
    return v;
}
__device__ __forceinline__ float rs_of(f32x4 a) { return rsqrtf(((a.x + a.y) + (a.z + a.w)) * (1.0f / 1024.0f) + EPS); }
__device__ __forceinline__ float row_rs(const float* ssq, int row) {
    return rs_of(*(const f32x4*)(ssq + (size_t)row * 4));
}

constexpr int BM = 256, BK = 64, HALF = 128, HTB = HALF * BK * 2, NXCD = 8, WGM = 4;
__device__ __forceinline__ int lds_byte(int r, int c) { const int st = (r >> 4) * 2 + (c >> 5), rr = r & 15, cc = c & 31, ob = rr * 64 + cc * 2; return st * 1024 + (ob ^ (((ob >> 9) & 1) << 5)); }
__device__ __forceinline__ void stage_rc(int b, int& R, int& C) { const int st = b / 1024, sb = b % 1024, swz = sb ^ (((sb >> 9) & 1) << 5); R = (st >> 1) * 16 + swz / 64; C = (st & 1) * 32 + (swz % 64) / 2; }
__device__ __forceinline__ int perm32(int rho) { const int n = rho >> 4, i = rho & 15; return 8 * (i >> 2) + 4 * n + (i & 3); }

struct Unit { int pm, pn; };
struct Gemm { const bf16_t* A; const bf16_t* Bt; int lda, ldb, K, nM, nN, pm_div; size_t a_pm, a_b, a_pn, b_pn, b_b; int c_shift; int a_div; };
struct StaticOrder {
    int nM, nN, nwg, G, c;
    __device__ void init(int nM_, int nN_, int G_, int c_) { nM = nM_; nN = nN_; nwg = nM * nN; G = G_; c = c_; }
    __device__ bool next(int i, Unit& u) const {
        const long L = (long)i * G + c; if (L >= nwg) return false;
        int wgid = (int)L; { const int q = nwg / NXCD, r = nwg % NXCD, xcd = wgid % NXCD, off = wgid / NXCD; wgid = (xcd < r ? xcd * (q + 1) : r * (q + 1) + (xcd - r) * q) + off; }
        const int nig = WGM * nN, gid = wgid / nig, fm = gid * WGM, gsz = (nM - fm) < WGM ? (nM - fm) : WGM;
        u.pm = fm + ((wgid % nig) % gsz); u.pn = (wgid % nig) / gsz; return true;
    }
};

typedef f32x4 Acc[2][2][4][2];

struct EpiGateUp {
    static constexpr bool PERM = true, XCH = false, RS = true;
    const float* ssq; bf16_t* act;
    __device__ __forceinline__ void operator()(Acc& acc, const Unit& u, int ui, int wr, int wc, int fr, int fq, LAS unsigned char* lds) const {
        const LAS float* rsT = (const LAS float*)(lds + LDS_RS) + ui * 256 + wr * 64 + fr;
        const int row0 = u.pm * BM + wr * 64 + fr, col0 = u.pn * 128 + wc * 32 + 8 * fq;
#pragma unroll
        for (int ai = 0; ai < 2; ++ai)
#pragma unroll
            for (int m = 0; m < 4; ++m) {
                const int row = row0 + ai * HALF + m * 16; const float r = rsT[ai * HALF + m * 16];
                const float c1 = -r * LOG2E, r2 = r * r;
                float o[8];
#pragma unroll
                for (int n = 0; n < 2; ++n) { const f32x4 g = acc[ai][0][m][n], up = acc[ai][1][m][n]; const f32x4 t = g * c1;
                    f32x4 e; e.x = __builtin_amdgcn_exp2f(t.x); e.y = __builtin_amdgcn_exp2f(t.y); e.z = __builtin_amdgcn_exp2f(t.z); e.w = __builtin_amdgcn_exp2f(t.w);
                    const f32x4 d = e + 1.0f; f32x4 rc; rc.x = __builtin_amdgcn_rcpf(d.x); rc.y = __builtin_amdgcn_rcpf(d.y); rc.z = __builtin_amdgcn_rcpf(d.z); rc.w = __builtin_amdgcn_rcpf(d.w);
                    const f32x4 v = (g * up) * (rc * r2);
                    o[n * 4 + 0] = v.x; o[n * 4 + 1] = v.y; o[n * 4 + 2] = v.z; o[n * 4 + 3] = v.w; }
                u32x4 w; w.x = cvt_pk_bf16(o[0], o[1]); w.y = cvt_pk_bf16(o[2], o[3]); w.z = cvt_pk_bf16(o[4], o[5]); w.w = cvt_pk_bf16(o[6], o[7]);
                *(u32x4*)(act + (size_t)row * FF + col0) = w;
            }
    }
};
struct EpiResid {
    static constexpr bool PERM = true, XCH = false, RS = false;
    bf16_t* xb; float* ssq; float alpha;
    __device__ __forceinline__ void operator()(Acc& acc, const Unit& u, int ui, int wr, int wc, int fr, int fq, LAS unsigned char* lds) const {
        LAS float* X = (LAS float*)(lds + LDS_XCH);
        const int row0 = u.pm * BM + wr * 64 + fr, col0 = u.pn * BM + wc * 32 + 8 * fq;
#pragma unroll
        for (int ai = 0; ai < 2; ++ai)
#pragma unroll
            for (int m = 0; m < 4; ++m) {
                const int row = row0 + ai * HALF + m * 16; bf16_t* xr = xb + (size_t)row * DM + col0; float q = 0.f;
                const u32x4 x0 = *(const u32x4*)xr, x1 = *(const u32x4*)(xr + HALF);
#pragma unroll
                for (int bj = 0; bj < 2; ++bj) { const u32x4 xo = bj ? x1 : x0; float v[8];
#pragma unroll
                    for (int n = 0; n < 2; ++n) { const f32x4 a = acc[ai][bj][m][n] * alpha;
                        v[4 * n + 0] = bf_lo(xo[2 * n]) + a.x; v[4 * n + 1] = bf_hi(xo[2 * n]) + a.y; v[4 * n + 2] = bf_lo(xo[2 * n + 1]) + a.z; v[4 * n + 3] = bf_hi(xo[2 * n + 1]) + a.w; }
#pragma unroll
                    for (int j = 0; j < 8; ++j) q += v[j] * v[j];
                    u32x4 w; w.x = cvt_pk_bf16(v[0], v[1]); w.y = cvt_pk_bf16(v[2], v[3]); w.z = cvt_pk_bf16(v[4], v[5]); w.w = cvt_pk_bf16(v[6], v[7]);
                    *(u32x4*)(xr + bj * HALF) = w; }
                q += __shfl_xor(q, 16); q += __shfl_xor(q, 32);
                if (fq == 0) X[(ai * HALF + wr * 64 + m * 16 + fr) * 4 + wc] = q;
            }
        asm volatile("s_waitcnt lgkmcnt(0)" ::: "memory"); __builtin_amdgcn_s_barrier(); asm volatile("" ::: "memory");
        const int t = (wr * 4 + wc) * 64 + fq * 16 + fr;
        if (t < 256) { const f32x4 v = *(const LAS f32x4*)(X + t * 4); ssq[(size_t)(u.pm * BM + t) * 4 + u.pn] = (v.x + v.y) + (v.z + v.w); }
        asm volatile("s_waitcnt lgkmcnt(0)" ::: "memory");
    }
};
struct EpiWin {
    static constexpr bool PERM = true, XCH = false, RS = true;
    const float* ssq; const float* cs; const float* sn; bf16_t* proj; bf16_t* qf; bf16_t* vtg;
    __device__ __forceinline__ void operator()(Acc& acc, const Unit& u, int ui, int wr, int wc, int fr, int fq, LAS unsigned char* lds) const {
        const LAS float* rsT = (const LAS float*)(lds + LDS_RS) + ui * 256 + wr * 64 + fr;
        const int row0 = u.pm * BM + wr * 64 + fr, tile = u.pn;
        const bool rope = (tile < 2) || (tile == 2 && wc < 2);
#pragma unroll
        for (int ai = 0; ai < 2; ++ai)
#pragma unroll
            for (int m = 0; m < 4; ++m) {
                const int row = row0 + ai * HALF + m * 16; float r = rsT[ai * HALF + m * 16];
                bf16_t* prow = proj + (size_t)row * INW;
                float o0[8], o1[8]; int c0, c1;
                if (rope) {
                    if (tile < 2) r *= QSCALE_SWA;
                    const f32x4 ca = *(const f32x4*)(cs + (size_t)row * 32 + 8 * fq), cb = *(const f32x4*)(cs + (size_t)row * 32 + 8 * fq + 4);
                    const f32x4 sa = *(const f32x4*)(sn + (size_t)row * 32 + 8 * fq), sb = *(const f32x4*)(sn + (size_t)row * 32 + 8 * fq + 4);
#pragma unroll
                    for (int n = 0; n < 2; ++n)
#pragma unroll
                        for (int j = 0; j < 4; ++j) { const float x1 = acc[ai][0][m][n][j] * r, x2 = acc[ai][1][m][n][j] * r; const float c = n ? cb[j] : ca[j], s = n ? sb[j] : sa[j];
                            o0[n * 4 + j] = x1 * c - x2 * s; o1[n * 4 + j] = x2 * c + x1 * s; }
                    c0 = (tile < 2 ? tile * 256 : 512) + wc * 64 + 8 * fq; c1 = c0 + 32;
                } else {
#pragma unroll
                    for (int n = 0; n < 2; ++n)
#pragma unroll
                        for (int j = 0; j < 4; ++j) { o0[n * 4 + j] = acc[ai][0][m][n][j] * r; o1[n * 4 + j] = acc[ai][1][m][n][j] * r; }
                    if (tile == 2) { c0 = 640 + 32 * (wc - 2) + 8 * fq; c1 = c0 + 64; }
                    else { c0 = tile * 256 + wc * 32 + 8 * fq; c1 = c0 + 128; }
                }
                u32x4 w0, w1; w0.x = cvt_pk_bf16(o0[0], o0[1]); w0.y = cvt_pk_bf16(o0[2], o0[3]); w0.z = cvt_pk_bf16(o0[4], o0[5]); w0.w = cvt_pk_bf16(o0[6], o0[7]);
                w1.x = cvt_pk_bf16(o1[0], o1[1]); w1.y = cvt_pk_bf16(o1[2], o1[3]); w1.z = cvt_pk_bf16(o1[4], o1[5]); w1.w = cvt_pk_bf16(o1[6], o1[7]);
                if (tile < 2) {
                    bf16_t* qb = qf + ((((size_t)(row >> 5) * 8 + tile * 4 + wc) * 4 + (fq >> 1)) * 2 + (fq & 1)) * 256 + (size_t)(row & 31) * 8;
                    *(u32x4*)qb = w0; *(u32x4*)(qb + 2 * 2 * 256) = w1;
                } else if (tile == 2 && wc >= 2) {
                    bf16_t* vb = vtg + ((size_t)(row >> 13) * 128 + 32 * (wc - 2) + 8 * fq) * SEQ + (row & (SEQ - 1));
#pragma unroll
                    for (int e = 0; e < 4; ++e) { vb[(size_t)(2 * e) * SEQ] = (bf16_t)(w0[e] & 0xffffu); vb[(size_t)(2 * e + 1) * SEQ] = (bf16_t)(w0[e] >> 16);
                        vb[(size_t)(64 + 2 * e) * SEQ] = (bf16_t)(w1[e] & 0xffffu); vb[(size_t)(64 + 2 * e + 1) * SEQ] = (bf16_t)(w1[e] >> 16); }
                } else { *(u32x4*)(prow + c0) = w0; *(u32x4*)(prow + c1) = w1; }
            }
    }
};
struct EpiBf16 {
    static constexpr bool PERM = true, XCH = false, RS = false;
    bf16_t* out; size_t tb_pm, tb_pn; int ldc, mode; float scale;
    __device__ __forceinline__ void operator()(Acc& acc, const Unit& u, int ui, int wr, int wc, int fr, int fq, LAS unsigned char*) const {
        size_t tb = (size_t)u.pm * tb_pm + (size_t)u.pn * tb_pn;
        if (mode) tb = (size_t)((u.pn >> 2) * 32 + ((u.pm >> 2) * 4 + (u.pn & 3)) * 4 + (u.pm & 3)) * 65536;
        bf16_t* o = out + tb + (size_t)(wr * 64 + fr) * ldc + wc * 32 + 8 * fq;
#pragma unroll
        for (int ai = 0; ai < 2; ++ai)
#pragma unroll
            for (int m = 0; m < 4; ++m) {
#pragma unroll
                for (int bj = 0; bj < 2; ++bj) { const f32x4 v0 = acc[ai][bj][m][0] * scale, v1 = acc[ai][bj][m][1] * scale;
                    u32x4 w; w.x = cvt_pk_bf16(v0.x, v0.y); w.y = cvt_pk_bf16(v0.z, v0.w); w.z = cvt_pk_bf16(v1.x, v1.y); w.w = cvt_pk_bf16(v1.z, v1.w);
                    *(u32x4*)(o + (size_t)(ai * HALF + m * 16) * ldc + bj * HALF) = w; }
            }
    }
};
struct EpiSoftmax {
    static constexpr bool PERM = true, XCH = true, RS = true;
    const float* ssq; bf16_t* out; int ldc;
    __device__ __forceinline__ void operator()(Acc& acc, const Unit& u, int ui, int wr, int wc, int fr, int fq, LAS unsigned char* lds) const {
        const LAS float* rsT = (const LAS float*)(lds + LDS_RS) + ui * 256 + wr * 64 + fr;
        typedef float f32x2v __attribute__((ext_vector_type(2)));
        LAS f32x2v* X = (LAS f32x2v*)(lds + LDS_XCH);
        float mw[2][4];
#pragma unroll
        for (int ai = 0; ai < 2; ++ai)
#pragma unroll
            for (int m = 0; m < 4; ++m) {
                float mx = -3.0e38f; const float r = rsT[ai * HALF + m * 16];
#pragma unroll
                for (int bj = 0; bj < 2; ++bj)
#pragma unroll
                    for (int n = 0; n < 2; ++n) { const f32x4 v = acc[ai][bj][m][n] * r; acc[ai][bj][m][n] = v; mx = fmaxf(mx, fmaxf(fmaxf(v.x, v.y), fmaxf(v.z, v.w))); }
                mx = fmaxf(mx, __shfl_xor(mx, 16)); mx = fmaxf(mx, __shfl_xor(mx, 32));
                float s = 0.f;
#pragma unroll
                for (int bj = 0; bj < 2; ++bj)
#pragma unroll
                    for (int n = 0; n < 2; ++n) { f32x4 v = acc[ai][bj][m][n];
                        v.x = __builtin_amdgcn_exp2f(v.x - mx); v.y = __builtin_amdgcn_exp2f(v.y - mx); v.z = __builtin_amdgcn_exp2f(v.z - mx); v.w = __builtin_amdgcn_exp2f(v.w - mx);
                        s += (v.x + v.y) + (v.z + v.w); acc[ai][bj][m][n] = v; }
                s += __shfl_xor(s, 16); s += __shfl_xor(s, 32);
                mw[ai][m] = mx;
                if (fq == 0) X[(ai * HALF + wr * 64 + m * 16 + fr) * 4 + wc] = (f32x2v){mx, s};
            }
        asm volatile("s_waitcnt lgkmcnt(0)" ::: "memory"); __builtin_amdgcn_s_barrier(); asm volatile("" ::: "memory");
        const int row0 = u.pm * BM + wr * 64 + fr, col0 = u.pn * BM + wc * 32 + 8 * fq;
#pragma unroll
        for (int ai = 0; ai < 2; ++ai)
#pragma unroll
            for (int m = 0; m < 4; ++m) {
                const int rl = ai * HALF + wr * 64 + m * 16 + fr;
                const f32x2v a = X[rl * 4 + 0], b = X[rl * 4 + 1], c = X[rl * 4 + 2], d = X[rl * 4 + 3];
                const float M = fmaxf(fmaxf(a.x, b.x), fmaxf(c.x, d.x));
                const float L = (a.y * __builtin_amdgcn_exp2f(a.x - M) + b.y * __builtin_amdgcn_exp2f(b.x - M)) + (c.y * __builtin_amdgcn_exp2f(c.x - M) + d.y * __builtin_amdgcn_exp2f(d.x - M));
                const float f = __builtin_amdgcn_exp2f(mw[ai][m] - M) / L;
                const int row = row0 + ai * HALF + m * 16;
#pragma unroll
                for (int bj = 0; bj < 2; ++bj) { const f32x4 v0 = acc[ai][bj][m][0] * f, v1 = acc[ai][bj][m][1] * f;
                    u32x4 w; w.x = cvt_pk_bf16(v0.x, v0.y); w.y = cvt_pk_bf16(v0.z, v0.w); w.z = cvt_pk_bf16(v1.x, v1.y); w.w = cvt_pk_bf16(v1.z, v1.w);
                    *(u32x4*)(out + drow((size_t)row) + col0 + bj * HALF) = w; }
            }
        asm volatile("s_waitcnt lgkmcnt(0)" ::: "memory");
    }
};

template <class Epi>
__device__ __forceinline__ void gemm_phase(LAS unsigned char* lds, const Gemm g, const Epi& E) {
    constexpr bool ALIGN_EPI = true;
    int tid_ = threadIdx.x; asm volatile("" : "+v"(tid_));
    const int tid = tid_, wid = __builtin_amdgcn_readfirstlane(tid >> 6), lane = tid & 63, wr = wid >> 2, wc = wid & 3, fr = lane & 15, fq = lane >> 4;
    const int nt = g.K / BK;
    const unsigned vcu = ((volatile LAS unsigned*)(lds + LDS_BARST))[2];
    StaticOrder S; S.init(g.nM, g.nN, (int)gridDim.x, (int)((vcu + gridDim.x - (unsigned)g.c_shift % gridDim.x) % gridDim.x));
    unsigned voffA[2], voffB[2];
#pragma unroll
    for (int i = 0; i < 2; ++i) { int R, C; stage_rc(tid * 16 + i * 8192, R, C); const int Rb = Epi::PERM ? ((R & ~31) + perm32(R & 31)) : R;
        voffA[i] = (unsigned)(R * g.lda + C) * 2u; voffB[i] = (unsigned)(Rb * g.ldb + C) * 2u; }
    const size_t kstep = (size_t)(BK * 2);
    const size_t hstepA = (size_t)HALF * g.lda * 2, hstepB = (size_t)HALF * g.ldb * 2;
    const unsigned ldsw = (unsigned)wid * 1024u;
    const int aoff = lds_byte(wr * 64 + fr, fq * 8), boff = lds_byte(wc * 32 + fr, fq * 8);
#define G_ABASE(u) ((const char*)(g.A + (size_t)((u).pm % (g.a_div ? g.a_div : g.pm_div)) * g.a_pm + (size_t)((u).pm / (g.a_div ? g.a_div : g.pm_div)) * g.a_b + (size_t)(u).pn * g.a_pn))
#define G_BBASE(u) ((const char*)(g.Bt + (size_t)(u).pn * g.b_pn + (size_t)((u).pm / g.pm_div) * g.b_b))
#define PG8_SA(b, h) (((b) * 2 + (h)) * HTB)
#define PG8_SB(b, h) ((4 + (b) * 2 + (h)) * HTB)
#define PG8_STAGE(bufoff, gbase, voff) do { _Pragma("unroll") for (int _i = 0; _i < 2; ++_i) \
        __builtin_amdgcn_global_load_lds((const unsigned*)((const char*)(gbase) + (voff)[_i]), (LAS unsigned*)(lds + (bufoff) + ldsw + _i * 8192), 16, 0, 0); } while (0)
#define PG8_LDA(dst, b, h) do { _Pragma("unroll") for (int m = 0; m < 4; ++m) _Pragma("unroll") for (int k = 0; k < 2; ++k) dst[m][k] = *(const LAS bf16x8*)(lds + PG8_SA(b, h) + aoff + m * 2048 + k * 1024); } while (0)
#define PG8_LDB(dst, b, h) do { _Pragma("unroll") for (int n = 0; n < 2; ++n) _Pragma("unroll") for (int k = 0; k < 2; ++k) dst[n][k] = *(const LAS bf16x8*)(lds + PG8_SB(b, h) + boff + n * 2048 + k * 1024); } while (0)
#define PG8_MMA(ai, bj, At, Bt) do { __builtin_amdgcn_s_setprio(1); _Pragma("unroll") for (int m = 0; m < 4; ++m) _Pragma("unroll") for (int n = 0; n < 2; ++n) _Pragma("unroll") for (int k = 0; k < 2; ++k) \
        acc[ai][bj][m][n] = __builtin_amdgcn_mfma_f32_16x16x32_bf16(Bt[n][k], At[m][k], acc[ai][bj][m][n], 0, 0, 0); __builtin_amdgcn_s_setprio(0); } while (0)
#define PG8_WAIT_V(n) asm volatile("s_waitcnt vmcnt(" #n ")" ::: "memory")
#define PG8_WAIT_L(n) asm volatile("s_waitcnt lgkmcnt(" #n ")" ::: "memory")
#define PG8_BAR __builtin_amdgcn_s_barrier()
#define PG8_SCHED __builtin_amdgcn_sched_barrier(0)
    Unit cur, nxt; int ui = 0;
    if (!S.next(0, cur)) return;
    Acc acc;
#pragma unroll
    for (int a = 0; a < 2; ++a)
#pragma unroll
        for (int b = 0; b < 2; ++b)
#pragma unroll
            for (int m = 0; m < 4; ++m)
#pragma unroll
                for (int n = 0; n < 2; ++n) acc[a][b][m][n] = (f32x4){0.f, 0.f, 0.f, 0.f};
    bf16x8 At[4][2], B0[2][2], B1[2][2];
    const char* cA = G_ABASE(cur); const char* cB = G_BBASE(cur);
    PG8_STAGE(PG8_SB(0, 0), cB, voffB); PG8_STAGE(PG8_SB(0, 1), cB + hstepB, voffB); PG8_STAGE(PG8_SA(0, 0), cA, voffA); PG8_STAGE(PG8_SA(0, 1), cA + hstepA, voffA);
    if constexpr (Epi::RS) {
        f32x4 pv[6]; bool ok[6];
#pragma unroll
        for (int j = 0; j < 6; ++j) { Unit tu; ok[j] = S.next((tid >> 8) + 2 * j, tu); pv[j] = (f32x4){0.f, 0.f, 0.f, 0.f}; if (ok[j]) pv[j] = *(const f32x4*)(E.ssq + (size_t)(tu.pm * BM + (tid & 255)) * 4); }
#pragma unroll
        for (int j = 0; j < 6; ++j) if (ok[j]) ((LAS float*)(lds + LDS_RS))[((tid >> 8) + 2 * j) * 256 + (tid & 255)] = rs_of(pv[j]);
        asm volatile("s_waitcnt lgkmcnt(0)" ::: "memory"); __builtin_amdgcn_s_barrier(); asm volatile("" ::: "memory");
    }
    if (wr == 1) PG8_BAR;
    PG8_WAIT_V(2); PG8_BAR;
    PG8_STAGE(PG8_SB(1, 0), cB + kstep, voffB); PG8_STAGE(PG8_SA(1, 0), cA + kstep, voffA); PG8_STAGE(PG8_SB(1, 1), cB + hstepB + kstep, voffB);
    PG8_WAIT_V(6); PG8_BAR;
    for (;;) {
        const bool has_next = S.next(ui + 1, nxt);
        const char* nA = has_next ? G_ABASE(nxt) : cA; const char* nB = has_next ? G_BBASE(nxt) : cB;
        for (int t = 0; t < nt; t += 2) {
            const bool last = (t == nt - 2);
            const char* a1 = cA + (size_t)(t + 1) * kstep;
            const char* a2 = last ? nA : cA + (size_t)(t + 2) * kstep; const char* b2 = last ? nB : cB + (size_t)(t + 2) * kstep;
            const char* a3 = a2 + kstep; const char* b3 = b2 + kstep;
            PG8_LDB(B0, 0, 0); PG8_LDB(B1, 0, 1); PG8_SCHED; PG8_LDA(At, 0, 0); PG8_STAGE(PG8_SA(1, 1), a1 + hstepA, voffA);
            PG8_WAIT_V(8); PG8_WAIT_L(0); PG8_BAR; PG8_MMA(0, 0, At, B0); PG8_MMA(0, 1, At, B1); PG8_BAR; PG8_SCHED;
            PG8_LDA(At, 0, 1); PG8_STAGE(PG8_SB(0, 0), b2, voffB); PG8_STAGE(PG8_SB(0, 1), b2 + hstepB, voffB); PG8_STAGE(PG8_SA(0, 0), a2, voffA);
            PG8_WAIT_V(8); PG8_WAIT_L(0); PG8_BAR; PG8_MMA(1, 0, At, B0); PG8_MMA(1, 1, At, B1); PG8_BAR; PG8_SCHED;
            PG8_LDB(B0, 1, 0); PG8_LDB(B1, 1, 1); PG8_SCHED; PG8_LDA(At, 1, 0); PG8_STAGE(PG8_SA(0, 1), a2 + hstepA, voffA);
            PG8_WAIT_V(8); PG8_WAIT_L(0); PG8_BAR; PG8_MMA(0, 0, At, B0); PG8_MMA(0, 1, At, B1); PG8_BAR; PG8_SCHED;
            PG8_LDA(At, 1, 1); PG8_STAGE(PG8_SB(1, 0), b3, voffB); PG8_STAGE(PG8_SB(1, 1), b3 + hstepB, voffB); PG8_STAGE(PG8_SA(1, 0), a3, voffA);
            PG8_WAIT_V(8); PG8_WAIT_L(0); PG8_BAR; PG8_MMA(1, 0, At, B0); PG8_MMA(1, 1, At, B1); PG8_BAR; PG8_SCHED;
        }
        if constexpr (ALIGN_EPI) { if (wr == 0) PG8_BAR; }
        E(acc, cur, ui, wr, wc, fr, fq, lds);
        if (!has_next) break;
#pragma unroll
        for (int a = 0; a < 2; ++a)
#pragma unroll
            for (int b = 0; b < 2; ++b)
#pragma unroll
                for (int m = 0; m < 4; ++m)
#pragma unroll
                    for (int n = 0; n < 2; ++n) acc[a][b][m][n] = (f32x4){0.f, 0.f, 0.f, 0.f};
        cur = nxt; cA = nA; cB = nB; ++ui;
        if constexpr (ALIGN_EPI) { if (wr == 1) PG8_BAR; }
    }
    PG8_WAIT_V(0);
    if constexpr (!ALIGN_EPI) { if (wr == 0) PG8_BAR; }
    PG8_BAR;
#undef G_ABASE
#undef G_BBASE
#undef PG8_SA
#undef PG8_SB
#undef PG8_STAGE
#undef PG8_LDA
#undef PG8_LDB
#undef PG8_MMA
#undef PG8_WAIT_V
#undef PG8_WAIT_L
#undef PG8_BAR
#undef PG8_SCHED
}

enum { MAP_ID = 0, MAP_GATE = 1, MAP_UP = 2, MAP_WIN = 3 };
__device__ __forceinline__ int map_row(int kind, int n) {
    if (kind == MAP_GATE) return 256 * (n >> 7) + (n & 127);
    if (kind == MAP_UP) return 256 * (n >> 7) + 128 + (n & 127);
    if (kind == MAP_WIN) {
        if (n < 512) { const int head = n >> 6, d = n & 63, tile = head >> 2, hh = head & 3; return 256 * tile + (d < 32 ? 32 * hh + d : 128 + 32 * hh + d - 32); }
        if (n < 640) { const int kh = (n - 512) >> 6, d = n & 63; return 512 + (d < 32 ? 32 * kh + d : 128 + 32 * kh + d - 32); }
        if (n < 768) { const int vc = n - 640; return 512 + (vc < 64 ? 64 + vc : 128 + 64 + (vc - 64)); }
        return n;
    }
    return n;
}
__device__ __forceinline__ void conv_item(const float* W, const float* gain, int K, int N, bf16_t* WT, int kind, bool hm, LAS float* scr, int item, int lane) {
    const int nblk = N / 32, kb = item / nblk, nb = item % nblk, k0 = 64 * kb, n0 = 32 * nb;
    {
        const int kr = lane >> 3, c4 = lane & 7; f32x4 v[8]; float gv[8];
#pragma unroll
        for (int i = 0; i < 8; ++i) { v[i] = __builtin_nontemporal_load((const f32x4*)(W + (size_t)(k0 + 8 * i + kr) * N + n0 + 4 * c4));     gv[i] = gain ? gain[k0 + 8 * i + kr] : 1.0f; }
#pragma unroll
        for (int i = 0; i < 8; ++i) { LAS float* d = scr + (8 * i + kr) * 33 + 4 * c4; d[0] = v[i].x * gv[i]; d[1] = v[i].y * gv[i]; d[2] = v[i].z * gv[i]; d[3] = v[i].w * gv[i]; }
    }
    asm volatile("s_waitcnt lgkmcnt(0)" ::: "memory");
    const int c = lane & 7;
#pragma unroll
    for (int j = 0; j < 4; ++j) { const int n = (lane >> 3) + 8 * j; const LAS float* s = scr + (8 * c) * 33 + n;
        u32x4 o; o.x = cvt_pk_bf16(s[0 * 33], s[1 * 33]); o.y = cvt_pk_bf16(s[2 * 33], s[3 * 33]); o.z = cvt_pk_bf16(s[4 * 33], s[5 * 33]); o.w = cvt_pk_bf16(s[6 * 33], s[7 * 33]);
        const int kc = k0 + 8 * c; bf16_t* dp = hm ? WT + ((size_t)(kc >> 8) * N + n0 + n) * 256 + (kc & 255) : WT + (size_t)map_row(kind, n0 + n) * K + kc;
        *(u32x4*)dp = o; }
    asm volatile("s_waitcnt lgkmcnt(0)" ::: "memory");
}

struct Params { const float* in[25]; float* out; unsigned char* ws; int ph_lo, ph_hi; };

__device__ __forceinline__ void prologue(const Params& p, LAS unsigned char* lds) {
    int tid_ = threadIdx.x; asm volatile("" : "+v"(tid_));
    const int tid = tid_, lane = tid & 63, wave = __builtin_amdgcn_readfirstlane(tid >> 6);
    LAS float* scr = (LAS float*)(lds + wave * 16384);
    const int gw = blockIdx.x * 8 + wave, NGW = gridDim.x * 8;
    unsigned char* ws = p.ws;
    constexpr int IPL = 1408 * 6 + 640 + 512 * 2 + 1024 + 32;
    for (int it = gw; it < 2 * IPL; it += NGW) {
        const int l = it / IPL; int r = it % IPL; size_t wl_extra = 0;
        unsigned char* wl = ws + OFF_W + (size_t)l * WL_BYTES;
        int wi, gi = -1, K = 1024, N = 1024, kind = MAP_ID; size_t wstride = SLOT, doff; bool in_wl = true, hm = false;
        if (r < 1408) { wi = 4; gi = 3; N = FF; kind = MAP_GATE; wstride = (size_t)DM * FF; doff = WO_GU1; }
        else if ((r -= 1408) < 1408) { wi = 5; gi = 3; N = FF; kind = MAP_UP; wstride = (size_t)DM * FF; doff = WO_GU1; }
        else if ((r -= 1408) < 1408) { wi = 6; K = FF; wstride = (size_t)DM * FF; doff = WO_D1; }
        else if ((r -= 1408) < 640) { wi = 8; gi = 7; N = INW; kind = MAP_WIN; wstride = (size_t)DM * INW; doff = WO_IN; }
        else if ((r -= 640) < 512) { wi = 14; doff = WO_OUT; }
        else if ((r -= 512) < 1024) { wi = 18; N = 2048; wstride = 2 * SLOT; in_wl = false; doff = OFF_WKV + (size_t)l * 2 * SLOT * 2; }
        else if ((r -= 1024) < 512) { wi = 19; in_wl = false; hm = true; doff = OFF_WOT + (size_t)l * SLOT * 2; }
        else if ((r -= 512) < 1408) { wi = 21; gi = 20; N = FF; kind = MAP_GATE; wstride = (size_t)DM * FF; doff = WO_GU2; }
        else if ((r -= 1408) < 1408) { wi = 22; gi = 20; N = FF; kind = MAP_UP; wstride = (size_t)DM * FF; doff = WO_GU2; }
        else if ((r -= 1408) < 1408) { wi = 23; K = FF; wstride = (size_t)DM * FF; doff = WO_D2; }
        else { r -= 1408; const int g4 = r >> 3; r &= 7; wi = 10; K = 128; N = 128; wstride = 4 * 128 * 128; doff = WO_PW + (size_t)g4 * 128 * 128 * 2; wl_extra = (size_t)g4 * 128 * 128; }
        const float* W = (wi == 4 ? p.in[4] : wi == 5 ? p.in[5] : wi == 6 ? p.in[6] : wi == 8 ? p.in[8] : wi == 14 ? p.in[14] : wi == 18 ? p.in[18] : wi == 19 ? p.in[19] : wi == 21 ? p.in[21] : wi == 22 ? p.in[22] : wi == 23 ? p.in[23] : p.in[10]) + (size_t)l * wstride + wl_extra;
        const float* gain = gi < 0 ? nullptr : (gi == 3 ? p.in[3] : gi == 7 ? p.in[7] : p.in[20]) + l * DM;
        bf16_t* dst = (bf16_t*)((in_wl ? wl : ws) + doff);
        conv_item(W, gain, K, N, dst, kind, hm, scr, r, lane);
    }
    for (int it = gw; it < 2 * 1024; it += NGW) {
        const int l = it >> 10, row = it & 1023;
        const f32x4* xr = (const f32x4*)(p.in[1] + (size_t)row * DM) + lane; const f32x4* gr = (const f32x4*)(p.in[16] + l * DM) + lane;
        f32x4 v[4]; float s = 0.f;
#pragma unroll
        for (int j = 0; j < 4; ++j) { v[j] = xr[64 * j]; s += (v[j].x * v[j].x + v[j].y * v[j].y) + (v[j].z * v[j].z + v[j].w * v[j].w); }
        const float r = rsqrtf(wave_sum(s) * (1.0f / 1024.0f) + EPS);
        bf16_t* oa = (bf16_t*)(ws + OFF_MEMN) + (size_t)l * SLOT + (size_t)row * DM;
#pragma unroll
        for (int j = 0; j < 4; ++j) { const f32x4 g = gr[64 * j]; u32x2 w; w.x = cvt_pk_bf16(v[j].x * r * g.x, v[j].y * r * g.y); w.y = cvt_pk_bf16(v[j].z * r * g.z, v[j].w * r * g.w);
            *((u32x2*)oa + lane + 64 * j) = w; }
    }
    for (int it = gw; it < 2 * 1024; it += NGW) {
        const int l = it >> 10, k = it & 1023;
        const f32x4* xr = (const f32x4*)(p.in[17] + (size_t)l * SLOT + (size_t)k * DM) + lane; const float g = p.in[15][l * DM + k];
        bf16_t* o = (bf16_t*)(ws + OFF_WQN) + (size_t)l * SLOT + (size_t)k * 256;
#pragma unroll
        for (int j = 0; j < 4; ++j) { const f32x4 v = xr[64 * j]; u32x2 w; w.x = cvt_pk_bf16(v.x * g, v.y * g); w.y = cvt_pk_bf16(v.z * g, v.w * g);
            *((u32x2*)(o + (size_t)j * 1024 * 256) + lane) = w; }
    }
    for (int rb = gw * 4; rb < MT; rb += NGW * 4) {
        f32x4 v[4][4];
#pragma unroll
        for (int q = 0; q < 4; ++q) { const f32x4* xr = (const f32x4*)(p.in[0] + (size_t)(rb + q) * DM) + lane;
#pragma unroll
            for (int j = 0; j < 4; ++j) v[q][j] = __builtin_nontemporal_load(xr + 64 * j); }
#pragma unroll
        for (int q = 0; q < 4; ++q) { float s = 0.f;
#pragma unroll
            for (int j = 0; j < 4; ++j) s += (v[q][j].x * v[q][j].x + v[q][j].y * v[q][j].y) + (v[q][j].z * v[q][j].z + v[q][j].w * v[q][j].w);
            s = wave_sum(s);
            bf16_t* o = (bf16_t*)(ws + OFF_XB) + (size_t)(rb + q) * DM;
#pragma unroll
            for (int j = 0; j < 4; ++j) { u32x2 w; w.x = cvt_pk_bf16(v[q][j].x, v[q][j].y); w.y = cvt_pk_bf16(v[q][j].z, v[q][j].w); *((u32x2*)o + lane + 64 * j) = w; }
            if (lane < 4) ((float*)(ws + OFF_SSQ))[(size_t)(rb + q) * 4 + lane] = (lane == 0) ? s : 0.f; }
    }
    {
        const int* pos = (const int*)p.in[2]; float* cs = (float*)(ws + OFF_COS); float* sn = (float*)(ws + OFF_SIN);
        const int gt = blockIdx.x * 512 + tid, NGT = gridDim.x * 512;
        for (int i = gt; i < MT * 32; i += NGT) { const int row = i >> 5, f = i & 31;
            const float inv = powf(10000.0f, -(float)(2 * f) / 64.0f); const float ang = (float)pos[row] * inv;
            cs[i] = cosf(ang); sn[i] = sinf(ang); }
    }
}

constexpr int MX_KS = 0, MX_KSTR = 272, MX_VT = 160 * 272, MX_VSTR = 328, MX_XA = 86016, MX_XB = 87040;
constexpr int MX_US = 88064, MX_PL = 0, MX_PSTR = 1040;
static_assert(MX_VT + 128 * MX_VSTR <= MX_XA && MX_PL + 32 * MX_PSTR <= MX_VT && MX_US + 47 * 1024 <= LDS_BYTES, "mixer LDS map");
__device__ __forceinline__ int crow(int r, int hi) { return (r & 3) + 8 * (r >> 2) + 4 * hi; }

template <int W> __device__ __forceinline__ void pool_w(const LAS unsigned* U, LAS unsigned char* pl, int t0, int ts, int cp) {
    unsigned uu[16 + W - 1];
#pragma unroll
    for (int i = 0; i < 16 + W - 1; ++i) uu[i] = U[(ts + 15 - (W - 1) + i) * 256];
    float s0 = 0.f, s1 = 0.f;
#pragma unroll
    for (int i = 0; i < W - 1; ++i) { s0 += bf_lo(uu[i]); s1 += bf_hi(uu[i]); }
#pragma unroll
    for (int t = 0; t < 16; ++t) {
        const float c0 = bf_lo(uu[W - 1 + t]), c1 = bf_hi(uu[W - 1 + t]); s0 += c0; s1 += c1;
        const int tp = t0 + ts + t + 1; const float inv = (tp < W) ? 1.0f / (float)tp : 1.0f / (float)W;
        *(LAS unsigned*)(pl + (ts + t) * MX_PSTR + cp * 4) = cvt_pk_bf16(s0 * inv - c0, s1 * inv - c1);
        s0 -= bf_lo(uu[t]); s1 -= bf_hi(uu[t]);
    }
}
constexpr int MX_TAB = LDS_RS;
static_assert(MX_TAB + 3 * 2048 <= LDS_BYTES && MX_US + 47 * 1024 <= LDS_BARST && MX_TAB > LDS_BARST + 16, "mixer LDS map (tables)");

#define MX_BAR() do { asm volatile("s_waitcnt lgkmcnt(0)" ::: "memory"); __builtin_amdgcn_s_barrier(); asm volatile("" ::: "memory"); } while (0)
__device__ __forceinline__ void mixer_phase(LAS unsigned char* lds, const bf16_t* proj, const bf16_t* qfg, const bf16_t* vtg, bf16_t* mrg, const bf16_t* pwT, const float* sinks, const float* gA, const float* gB, const float* pscale) {
    int tid_ = threadIdx.x;
    {
        asm volatile("" : "+v"(tid_));
        LAS float* tab = (LAS float*)(lds + MX_TAB);
        tab[tid_] = gA[tid_]; tab[512 + tid_] = gB[tid_]; tab[1024 + tid_] = pscale[tid_];
    }
    const int vcu = (int)((volatile LAS unsigned*)(lds + LDS_BARST))[2];
    for (int unit0 = vcu; unit0 < MT / 32; unit0 += gridDim.x) {
        const int unit = (gridDim.x == 256) ? 128 * (vcu & 7) + (vcu >> 3) + 32 * (unit0 >> 8) : unit0;
        asm volatile("" : "+v"(tid_));
        const int tid = tid_, lane = tid & 63, wid = __builtin_amdgcn_readfirstlane(tid >> 6), r32 = lane & 31, hi = lane >> 5;
        const int b = unit >> 8, t0 = (unit & 255) * 32; const size_t row0 = (size_t)b * SEQ + t0;
#pragma unroll
        for (int i = 0; i < 5; ++i) { const int idx = tid + 512 * i, key = idx >> 4, ch = idx & 15; u32x4 v = (u32x4){0u, 0u, 0u, 0u};
            if (t0 - 128 + key >= 0) v = *(const u32x4*)(proj + (row0 - 128 + key) * INW + 512 + ch * 8);
            *(LAS u32x4*)(lds + MX_KS + key * MX_KSTR + ch * 16) = v; }
#pragma unroll
        for (int i = 0; i < 5; ++i) { const int idx = tid + 512 * i, chn = idx / 20, key0 = (idx % 20) * 8; u32x4 v = (u32x4){0u, 0u, 0u, 0u};
            if (t0 - 128 + key0 >= 0) v = *(const u32x4*)(vtg + ((size_t)b * 128 + chn) * SEQ + (t0 - 128 + key0));
            LAS u32x2* vt = (LAS u32x2*)(lds + MX_VT + chn * MX_VSTR + key0 * 2); vt[0] = (u32x2){v.x, v.y}; vt[1] = (u32x2){v.z, v.w}; }
#pragma unroll
        for (int i = 0; i < 6; ++i) { const int idx = tid + 512 * i; if (idx < 47 * 64) { const int lr = idx >> 6, ch = idx & 63; u32x4 v = (u32x4){0u, 0u, 0u, 0u};
                if (t0 + lr - 15 >= 0) v = *(const u32x4*)(proj + (row0 + lr - 15) * INW + 768 + ch * 8);
                *(LAS u32x4*)(lds + MX_US + lr * 1024 + ch * 16) = v; } }
        bf16x8 qf[4];
#pragma unroll
        for (int ks = 0; ks < 4; ++ks) qf[ks] = *(const bf16x8*)(qfg + ((((size_t)unit * 8 + wid) * 4 + ks) * 2 + hi) * 256 + r32 * 8);
        MX_BAR();
        const int kvh = wid >> 2;
        f32x16 s[5];
#pragma unroll
        for (int kt = 0; kt < 5; ++kt) {
            f32x16 a = (f32x16){0.f, 0.f, 0.f, 0.f, 0.f, 0.f, 0.f, 0.f, 0.f, 0.f, 0.f, 0.f, 0.f, 0.f, 0.f, 0.f};
#pragma unroll
            for (int ks = 0; ks < 4; ++ks) { const bf16x8 kf = *(const LAS bf16x8*)(lds + MX_KS + (32 * kt + r32) * MX_KSTR + (kvh * 64 + ks * 16 + hi * 8) * 2);
                a = __builtin_amdgcn_mfma_f32_32x32x16_bf16(kf, qf[ks], a, 0, 0, 0); }
            s[kt] = a;
        }
        const float sink2 = sinks[wid] * LOG2E;
        float mx = sink2;
        if (t0 >= 128) {
#pragma unroll
            for (int r = 0; r < 16; ++r) { const int k0 = crow(r, hi); if (k0 <= r32) s[0][r] = -1.0e30f; if (k0 > r32) s[4][r] = -1.0e30f; }
        } else {
#pragma unroll
            for (int kt = 0; kt < 5; ++kt)
#pragma unroll
                for (int r = 0; r < 16; ++r) { const int kk = 32 * kt + crow(r, hi); const int diff = (128 + r32) - kk;
                    const bool ok = (diff >= 0) && (diff < 128) && (t0 - 128 + kk >= 0); if (!ok) s[kt][r] = -1.0e30f; }
        }
#pragma unroll
        for (int kt = 0; kt < 5; ++kt)
#pragma unroll
            for (int r = 0; r < 16; ++r) mx = fmaxf(mx, s[kt][r]);
        mx = fmaxf(mx, __shfl_xor(mx, 32));
        float lsum = 0.f;
#pragma unroll
        for (int kt = 0; kt < 5; ++kt)
#pragma unroll
            for (int r = 0; r < 16; ++r) { const float e = __builtin_amdgcn_exp2f(s[kt][r] - mx); s[kt][r] = e; lsum += e; }
        lsum += __shfl_xor(lsum, 32); lsum += __builtin_amdgcn_exp2f(sink2 - mx);
        const float linv = 1.0f / lsum;
        f32x16 o[2];
#pragma unroll
        for (int dh = 0; dh < 2; ++dh) {
            f32x16 a = (f32x16){0.f, 0.f, 0.f, 0.f, 0.f, 0.f, 0.f, 0.f, 0.f, 0.f, 0.f, 0.f, 0.f, 0.f, 0.f, 0.f};
            const LAS unsigned char* vrow = lds + MX_VT + (kvh * 64 + 32 * dh + r32) * MX_VSTR;
#pragma unroll
            for (int kt = 0; kt < 5; ++kt)
#pragma unroll
                for (int st = 0; st < 2; ++st) {
                    const int key0 = 32 * kt + 16 * st + 4 * hi;
                    const u32x2 v0 = *(const LAS u32x2*)(vrow + key0 * 2), v1 = *(const LAS u32x2*)(vrow + (key0 + 8) * 2);
                    u32x4 av; av.x = v0.x; av.y = v0.y; av.z = v1.x; av.w = v1.y;
                    u32x4 pv; pv.x = cvt_pk_bf16(s[kt][8 * st + 0], s[kt][8 * st + 1]); pv.y = cvt_pk_bf16(s[kt][8 * st + 2], s[kt][8 * st + 3]);
                    pv.z = cvt_pk_bf16(s[kt][8 * st + 4], s[kt][8 * st + 5]); pv.w = cvt_pk_bf16(s[kt][8 * st + 6], s[kt][8 * st + 7]);
                    a = __builtin_amdgcn_mfma_f32_32x32x16_bf16(__builtin_bit_cast(bf16x8, av), __builtin_bit_cast(bf16x8, pv), a, 0, 0, 0);
                    if (st) __builtin_amdgcn_sched_barrier(0);
                }
            o[dh] = a;
        }
        float q2 = 0.f;
#pragma unroll
        for (int dh = 0; dh < 2; ++dh)
#pragma unroll
            for (int r = 0; r < 16; ++r) { const float v = o[dh][r] * linv; o[dh][r] = v; q2 += v * v; }
        q2 += __shfl_xor(q2, 32);
        if (hi == 0) ((LAS float*)(lds + MX_XA))[wid * 32 + r32] = q2;
        MX_BAR();
        {
            float tot = 0.f;
#pragma unroll
            for (int w = 0; w < 8; ++w) tot += ((LAS float*)(lds + MX_XA))[w * 32 + r32];
            const float rA = rsqrtf(tot * (1.0f / 512.0f) + EPS);
            bf16_t* orow = mrg + drow(row0 + r32) + wid * 64;
#pragma unroll
            for (int dh = 0; dh < 2; ++dh)
#pragma unroll
                for (int pq = 0; pq < 2; ++pq) { u32x2 w2[2];
#pragma unroll
                    for (int h2 = 0; h2 < 2; ++h2) { const int rq = 2 * pq + h2, d0 = 32 * dh + 8 * rq + 4 * hi; const f32x4 g = *(const LAS f32x4*)(lds + MX_TAB + (wid * 64 + d0) * 4);
                        w2[h2].x = cvt_pk_bf16(o[dh][4 * rq + 0] * rA * g.x, o[dh][4 * rq + 1] * rA * g.y); w2[h2].y = cvt_pk_bf16(o[dh][4 * rq + 2] * rA * g.z, o[dh][4 * rq + 3] * rA * g.w); }
                    *(u32x4*)(orow + 32 * dh + 16 * pq + 8 * hi) = pair16(w2[0], w2[1]); }
        }
        bf16x8 wf[2][8];
#pragma unroll
        for (int e = 0; e < 2; ++e)
#pragma unroll
            for (int ks = 0; ks < 8; ++ks) wf[e][ks] = *(const bf16x8*)(pwT + ((size_t)((wid >> 1) * 128 + 32 * (2 * (wid & 1) + e) + r32)) * 128 + hi * 8 + ks * 16);
        {
            const int cp = tid & 255, ts = 16 * (tid >> 8), gsel = __builtin_amdgcn_readfirstlane(cp >> 6);
            const LAS unsigned* U = (const LAS unsigned*)(lds + MX_US) + cp;
            if (gsel == 0) pool_w<2>(U, lds + MX_PL, t0, ts, cp); else if (gsel == 1) pool_w<4>(U, lds + MX_PL, t0, ts, cp);
            else if (gsel == 2) pool_w<8>(U, lds + MX_PL, t0, ts, cp); else pool_w<16>(U, lds + MX_PL, t0, ts, cp);
        }
        MX_BAR();
        {
            const int g = wid >> 1, nh = wid & 1;
            f32x16 acc2[2];
#pragma unroll
            for (int e = 0; e < 2; ++e) {
                f32x16 a = (f32x16){0.f, 0.f, 0.f, 0.f, 0.f, 0.f, 0.f, 0.f, 0.f, 0.f, 0.f, 0.f, 0.f, 0.f, 0.f, 0.f};
#pragma unroll
                for (int ks = 0; ks < 8; ++ks) { const bf16x8 af = wf[e][ks];
                    const bf16x8 bfr = *(const LAS bf16x8*)(lds + MX_PL + r32 * MX_PSTR + (g * 128 + ks * 16 + hi * 8) * 2);
                    a = __builtin_amdgcn_mfma_f32_32x32x16_bf16(af, bfr, a, 0, 0, 0); }
                acc2[e] = a;
            }
            float q3 = 0.f;
#pragma unroll
            for (int e = 0; e < 2; ++e)
#pragma unroll
                for (int rq = 0; rq < 4; ++rq) { const int ch = g * 128 + 32 * (2 * nh + e) + 8 * rq + 4 * hi; const f32x4 sc = *(const LAS f32x4*)(lds + MX_TAB + (1024 + ch) * 4);
#pragma unroll
                    for (int j = 0; j < 4; ++j) { const float v = acc2[e][4 * rq + j] * sc[j]; acc2[e][4 * rq + j] = v; q3 += v * v; } }
            q3 += __shfl_xor(q3, 32);
            if (hi == 0) ((LAS float*)(lds + MX_XB))[wid * 32 + r32] = q3;
            MX_BAR();
            float tot = 0.f;
#pragma unroll
            for (int w = 0; w < 8; ++w) tot += ((LAS float*)(lds + MX_XB))[w * 32 + r32];
            const float rB = rsqrtf(tot * (1.0f / 512.0f) + EPS);
            bf16_t* orow = mrg + drow(row0 + r32) + 512;
#pragma unroll
            for (int e = 0; e < 2; ++e)
#pragma unroll
                for (int pq = 0; pq < 2; ++pq) { u32x2 w2[2];
#pragma unroll
                    for (int h2 = 0; h2 < 2; ++h2) { const int rq = 2 * pq + h2, ch = g * 128 + 32 * (2 * nh + e) + 8 * rq + 4 * hi; const f32x4 gg = *(const LAS f32x4*)(lds + MX_TAB + (512 + ch) * 4);
                        w2[h2].x = cvt_pk_bf16(acc2[e][4 * rq + 0] * rB * gg.x, acc2[e][4 * rq + 1] * rB * gg.y); w2[h2].y = cvt_pk_bf16(acc2[e][4 * rq + 2] * rB * gg.z, acc2[e][4 * rq + 3] * rB * gg.w); }
                    *(u32x4*)(orow + g * 128 + 32 * (2 * nh + e) + 16 * pq + 8 * hi) = pair16(w2[0], w2[1]); }
        }
    }
}

#define XB_TMO      128
#define XB_XCNT(j)  (256  + 64 * (j))
#define XB_XSUB(j)  (1280 + 64 * (j))
#define XB_XGEN(j)  (2304 + 64 * (j))
#define XB_TOP      3328
#define XB_TOPGEN   3392
#define XCD_BAR_WORDS 3456
#define XB_SPIN_CAP (1u << 18)

__device__ __forceinline__ unsigned xb_ld(unsigned* p)              { return __hip_atomic_load(p, __ATOMIC_RELAXED, __HIP_MEMORY_SCOPE_AGENT); }
__device__ __forceinline__ unsigned xb_add(unsigned* p, unsigned v) { return __hip_atomic_fetch_add(p, v, __ATOMIC_RELAXED, __HIP_MEMORY_SCOPE_AGENT); }
__device__ __forceinline__ unsigned xb_xcc_id() { return (unsigned)__builtin_amdgcn_s_getreg((3 << 11) | 20) & 0xFu; }
#define XB_SPIN(cond, bar) do { unsigned _sp = 0; while (cond) { __builtin_amdgcn_s_sleep(1); \
    if ((++_sp & 255u) == 0u) { if (xb_ld(&(bar)[XB_TMO])) break; if (_sp > XB_SPIN_CAP) { atomicAdd(&(bar)[XB_TMO], 1u); break; } } } } while (0)

struct XcdBarrier {
    unsigned* bar; unsigned x;
    volatile LAS unsigned* st;
};

__device__ __forceinline__ XcdBarrier xcd_barrier_post(unsigned* bar, volatile LAS unsigned* st) {
    XcdBarrier b; b.bar = bar; b.x = xb_xcc_id(); b.st = st;
    if (threadIdx.x == 0) (void)xb_add(&bar[XB_XCNT(b.x)], 1u);
    return b;
}
__device__ __forceinline__ void xcd_barrier_complete(unsigned* bar, unsigned x, unsigned& nloc, unsigned& nx) {
    const unsigned G = gridDim.x * gridDim.y * gridDim.z;
    unsigned sum, cnt, mine, sp = 0u;
    for (;;) {
        sum = 0u; cnt = 0u; mine = 0u;
#pragma unroll
        for (unsigned j = 0; j < 16; ++j) { const unsigned c = xb_ld(&bar[XB_XCNT(j)]); sum += c; cnt += (c > 0u) ? 1u : 0u; mine = (j == x) ? c : mine; }
        if (sum == G) break;
        __builtin_amdgcn_s_sleep(1);
        if ((++sp & 255u) == 0u) { if (xb_ld(&bar[XB_TMO])) break; if (sp > XB_SPIN_CAP) { atomicAdd(&bar[XB_TMO], 1u); break; } }
    }
    nloc = mine > 0u ? mine : 1u; nx = cnt > 0u ? cnt : 1u;
}

__device__ __forceinline__ void xcd_barrier(const XcdBarrier& b) {
    asm volatile("s_waitcnt vmcnt(0)" ::: "memory");
    __syncthreads();
    if (threadIdx.x == 0) {
        unsigned* bar = b.bar;
        __builtin_amdgcn_s_waitcnt(0);
        unsigned nloc = b.st[0], nx = b.st[1];
        if (nloc == 0u) { xcd_barrier_complete(bar, b.x, nloc, nx); b.st[0] = nloc; b.st[1] = nx; }
        const unsigned old = xb_add(&bar[XB_XSUB(b.x)], 1u);
        const unsigned gen = old / nloc;
        if (old + 1u == (gen + 1u) * nloc) {
            __builtin_amdgcn_fence(__ATOMIC_RELEASE, "agent");
            asm volatile("s_waitcnt vmcnt(0)" ::: "memory");
            const unsigned og = xb_add(&bar[XB_TOP], 1u);
            const unsigned tg = og / nx;
            if (og + 1u == (tg + 1u) * nx) xb_add(&bar[XB_TOPGEN], 1u);
            else XB_SPIN(xb_ld(&bar[XB_TOPGEN]) == tg, bar);
            __builtin_amdgcn_fence(__ATOMIC_ACQUIRE, "agent");
            xb_add(&bar[XB_XGEN(b.x)], 1u);
            asm volatile("s_waitcnt vmcnt(0)" ::: "memory");
        } else {
            XB_SPIN(xb_ld(&bar[XB_XGEN(b.x)]) == gen, bar);
            __builtin_amdgcn_fence(__ATOMIC_ACQUIRE, "agent");
            asm volatile("s_waitcnt vmcnt(0)" ::: "memory");
        }
    }
    __syncthreads();
}

#define XL_SUB(j)   (3456 + 64 * (j))
#define XL_GEN(j)   (3456 + 1024 + 64 * (j))
__device__ __forceinline__ void xcd_local_barrier(unsigned* bar, unsigned x, unsigned nloc) {
    asm volatile("s_waitcnt vmcnt(0)" ::: "memory");
    __syncthreads();
    if (threadIdx.x == 0) {
        __builtin_amdgcn_s_waitcnt(0);
        const unsigned old = xb_add(&bar[XL_SUB(x)], 1u);
        const unsigned gen = old / nloc;
        if (old + 1u == (gen + 1u) * nloc) xb_add(&bar[XL_GEN(x)], 1u);
        else XB_SPIN(xb_ld(&bar[XL_GEN(x)]) == gen, bar);
        __builtin_amdgcn_fence(__ATOMIC_ACQUIRE, "agent");
        asm volatile("s_waitcnt vmcnt(0)" ::: "memory");
    }
    __syncthreads();
}

constexpr int N_HEAD = 1, N_SUB = 9, N_PHASES = N_HEAD + 2 * N_SUB + 1;
__global__ void __launch_bounds__(512) hymba_fwd(Params p) {
    extern __shared__ __attribute__((aligned(16))) unsigned char lds_raw[];
    LAS unsigned char* lds = (LAS unsigned char*)lds_raw;
    unsigned char* ws = p.ws;
    bf16_t* XB = (bf16_t*)(ws + OFF_XB); bf16_t* ACT = (bf16_t*)(ws + OFF_ACT); bf16_t* PROJ = (bf16_t*)(ws + OFF_PROJ); bf16_t* MRG = (bf16_t*)((unsigned char*)p.out + DO_MRG); bf16_t* PB = (bf16_t*)((unsigned char*)p.out + DO_P);
    float* SSQ = (float*)(ws + OFF_SSQ);
    const size_t BIG = (size_t)256 * 1024;
    volatile LAS unsigned* MISCW = (volatile LAS unsigned*)(lds + LDS_BARST);
    if (threadIdx.x < 8) MISCW[threadIdx.x] = (threadIdx.x == 2) ? blockIdx.x : 0u;
    __syncthreads();
    if (threadIdx.x == 0) { const unsigned x_ = xb_xcc_id(); MISCW[5] = x_; MISCW[4] = xb_add(&((unsigned*)(ws + OFF_CTL))[XB_XCNT(x_)], 1u); }
    if (p.ph_lo <= 0 && 0 < p.ph_hi) { for (int rep = 0; rep <= PROBE_PRO; ++rep) { if (rep) GSYNC(); prologue(p, lds); __syncthreads(); } }
    bool synced = false;
    if (p.ph_lo == 0 && p.ph_hi > 1) {
        GSYNC(); synced = true;
        if (threadIdx.x == 0) {
            unsigned* bar = (unsigned*)(ws + OFF_CTL); bool ok = (gridDim.x == 256);
            for (unsigned j = 0; j < 16; ++j) { const unsigned c = xb_ld(&bar[XB_XCNT(j)]); ok = ok && (c == (j < 8 ? 32u : 0u)); }
            if (ok && MISCW[4] < 32u && MISCW[5] < 8u) { MISCW[2] = MISCW[4] * 8u + MISCW[5]; MISCW[3] = 1u; }
        }
        __syncthreads();
    }
    const int ph_a = p.ph_lo > N_HEAD ? p.ph_lo : N_HEAD, ph_b = p.ph_hi < N_PHASES - 1 ? p.ph_hi : N_PHASES - 1;
    for (int ph = ph_a; ph < ph_b; ++ph) {
        const int l = (ph - N_HEAD) / N_SUB, sp = (ph - N_HEAD) % N_SUB;
        for (int rep = 0; rep <= ((PROBE_MASK >> sp) & 1); ++rep) {
        if (rep || (ph > p.ph_lo && !(synced && ph == N_HEAD))) SEAM(!rep && !(l == 0 && sp == 0) && sp != 3 && !(sp == 4 && l == 0));
        unsigned char* wl = ws + OFF_W + (size_t)l * WL_BYTES;
        if (sp == 0 || sp == 7) {
            Gemm g{XB, (const bf16_t*)(wl + (sp == 0 ? WO_GU1 : WO_GU2)), 1024, 1024, 1024, 128, 22, 1 << 30, BIG, 0, 0, BIG, 0, 0};
            EpiGateUp E{SSQ, ACT};
            gemm_phase<EpiGateUp>(lds, g, E);
        } else if (sp == 1 || sp == 8 || sp == 4 || sp == 6) {
            Gemm g;
            if (sp == 1 || sp == 8) g = Gemm{ACT, (const bf16_t*)(wl + (sp == 1 ? WO_D1 : WO_D2)), FF, FF, FF, 128, 4, 1 << 30, (size_t)256 * FF, 0, 0, (size_t)256 * FF, 0, 0};
            else if (sp == 4) g = Gemm{MRG, (const bf16_t*)(wl + WO_OUT), 1024, 1024, 1024, 128, 4, 1 << 30, BIG, (size_t)1 << 23, 0, BIG, 0, 0, 16};
            else g = Gemm{PB, (const bf16_t*)(ws + OFF_WVO) + (size_t)l * 4 * SLOT, 1024, 1024, 1024, 128, 4, 32, BIG, (size_t)1 << 23, 0, BIG, SLOT, 0, 16};
            EpiResid E{XB, SSQ, (sp == 1 || sp == 8) ? 0.5f : 1.0f};
            gemm_phase<EpiResid>(lds, g, E);
        } else if (sp == 2) {
            Gemm g{XB, (const bf16_t*)(wl + WO_IN), 1024, 1024, 1024, 128, 5, 1 << 30, BIG, 0, 0, BIG, 0, 0};
            EpiWin E{SSQ, (const float*)(ws + OFF_COS), (const float*)(ws + OFF_SIN), PROJ, (bf16_t*)(ws + OFF_QF), (bf16_t*)(ws + OFF_VTG)};
            gemm_phase<EpiWin>(lds, g, E);
        } else if (sp == 3) {
            mixer_phase(lds, PROJ, (const bf16_t*)(ws + OFF_QF), (const bf16_t*)(ws + OFF_VTG), MRG, (const bf16_t*)(wl + WO_PW), p.in[9] + l * 8, p.in[12] + l * 512, p.in[13] + l * 512, p.in[11] + l * 512);
        } else if (sp == 5) {
            Gemm g{XB, (const bf16_t*)(ws + OFF_WQK) + (size_t)l * 4 * SLOT, 1024, 1024, 1024, 128, 4, 32, BIG, 32 * BIG, 0, BIG, SLOT, 0};
            EpiSoftmax E{SSQ, PB, 1024};
            gemm_phase<EpiSoftmax>(lds, g, E);
        }
        const int nbf = (l == 0 && rep == 0) ? (sp == 2 ? 1 : sp == 3 ? 16 : 0) : 0;
        for (int i = 0; i < nbf; ++i) {
            Gemm g; EpiBf16 E;
            if (sp == 2) {
                g = Gemm{(const bf16_t*)(ws + OFF_MEMN), (const bf16_t*)(ws + OFF_WKV), 1024, 1024, 1024, 8, 8, 4, BIG, 4 * BIG, 0, BIG, 2 * SLOT, 128};
                E = EpiBf16{(bf16_t*)(ws + OFF_KVH), 0, 0, 256, 1, 1.0f};
            } else {
                const int lh = i & 7, l2 = lh >> 2, h = lh & 3;
                if (i < 8) {
                    g = Gemm{(const bf16_t*)(ws + OFF_KVH) + (size_t)(lh * 4) * 65536, (const bf16_t*)(ws + OFF_WQN) + (size_t)lh * 262144, 256, 256, 256, 4, 4, 1 << 30, 65536, 0, 0, 65536, 0, 16 * i};
                    E = EpiBf16{(bf16_t*)(ws + OFF_WQK) + (size_t)l2 * 4 * SLOT + (size_t)h * 256 * 1024, SLOT, 256, 1024, 0, QSCALE_X};
                } else {
                    g = Gemm{(const bf16_t*)(ws + OFF_WOT) + (size_t)lh * 262144, (const bf16_t*)(ws + OFF_KVH) + (size_t)(32 + lh * 4) * 65536, 256, 256, 256, 4, 4, 1 << 30, 65536, 0, 0, 65536, 0, 16 * i};
                    E = EpiBf16{(bf16_t*)(ws + OFF_WVO) + (size_t)l2 * 4 * SLOT + (size_t)h * 256, BIG, SLOT, 1024, 0, 1.0f};
                }
            }
            gemm_phase<EpiBf16>(lds, g, E);
        }
        }
    }
    if (p.ph_lo <= N_PHASES - 1 && N_PHASES - 1 < p.ph_hi) {
        if (N_PHASES - 1 > p.ph_lo) SEAM(true);
        int tid_ = threadIdx.x; asm volatile("" : "+v"(tid_));
        const int vcu = (int)MISCW[2]; const int lane = tid_ & 63, gw = vcu * 8 + (tid_ >> 6), NGW = gridDim.x * 8;
        for (int row0 = gw; row0 < MT; row0 += NGW) {
            const int k_ = row0 / NGW;
            const int row = (gridDim.x == 256) ? 4096 * (vcu & 7) + 128 * (vcu >> 3) + 16 * (tid_ >> 6) + k_ : row0;
            const float r = row_rs(SSQ, row); const u32x2* xr = (const u32x2*)(XB + (size_t)row * DM) + lane; f32x4* orow = (f32x4*)(p.out + (size_t)row * DM) + lane; const f32x4* gr = (const f32x4*)p.in[24] + lane;
#pragma unroll
            for (int j = 0; j < 4; ++j) { const u32x2 v = xr[64 * j]; const f32x4 g = gr[64 * j]; __builtin_nontemporal_store((f32x4){bf_lo(v.x) * r * g.x, bf_hi(v.x) * r * g.y, bf_lo(v.y) * r * g.z, bf_hi(v.y) * r * g.w}, orow + 64 * j); }
        }
    }
}

extern "C" void kernel_launch(void* const* d_in, const int* in_sizes, int n_in, void* d_out, int out_size, void* d_ws, size_t ws_size, hipStream_t stream) {
    static int grid = 0;
    if (grid == 0) {
        if (n_in != 25 || out_size != MT * DM || ws_size < WS_END) { fprintf(stderr, "kernel_launch: unexpected shapes (n_in %d out %d ws %zu need %zu)\n", n_in, out_size, ws_size, (size_t)WS_END); grid = -1; return; }
        int dev = 0, cus = 0, per_cu = 0;
        hipGetDevice(&dev); hipDeviceGetAttribute(&cus, hipDeviceAttributeMultiprocessorCount, dev);
        if (hipFuncSetAttribute((const void*)hymba_fwd, hipFuncAttributeMaxDynamicSharedMemorySize, LDS_BYTES) != hipSuccess) { fprintf(stderr, "kernel_launch: hipFuncSetAttribute failed\n"); grid = -1; return; }
        if (hipOccupancyMaxActiveBlocksPerMultiprocessor(&per_cu, (const void*)hymba_fwd, 512, LDS_BYTES) != hipSuccess || per_cu < 1) { fprintf(stderr, "kernel_launch: occupancy query gave %d\n", per_cu); per_cu = 1; }
        (void)hipGetLastError();
        grid = cus;
    }
    if (grid < 0) return;
    Params p{};
    for (int i = 0; i < 25; ++i) p.in[i] = (const float*)d_in[i];
    p.out = (float*)d_out; p.ws = (unsigned char*)d_ws;
#if MK_ONE_LAUNCH
    p.ph_lo = 0; p.ph_hi = N_PHASES;
    if (hipMemsetAsync((char*)d_ws + OFF_CTL, 0, CTL_BYTES, stream) != hipSuccess) { fprintf(stderr, "kernel_launch: memset of the barrier words failed\n"); return; }
    void* args[] = {&p};
    hipError_t e = hipLaunchCooperativeKernel((const void*)hymba_fwd, dim3(grid), dim3(512), args, LDS_BYTES, stream);
    if (e != hipSuccess) fprintf(stderr, "cooperative launch failed: %s (grid %d)\n", hipGetErrorString(e), grid);
#else
    for (int ph = 0; ph < N_PHASES; ++ph) { p.ph_lo = ph; p.ph_hi = ph + 1; hipLaunchKernelGGL(hymba_fwd, dim3(grid), dim3(512), LDS_BYTES, stream, p); }
#endif
}
```

```cpp
#include <hip/hip_runtime.h>
#include <hip/hip_cooperative_groups.h>
#include <cstdio>
#include <cstdint>
namespace cg = cooperative_groups;

#ifndef MK_ONE_LAUNCH
#define MK_ONE_LAUNCH 1
#endif
#ifndef PROBE_MASK
#define PROBE_MASK 0
#endif
#ifndef PROBE_PRO
#define PROBE_PRO 0
#endif
#ifndef PROBE_NSYNC
#define PROBE_NSYNC 1
#endif
#define SEAM(local_ok_) do { if ((local_ok_) && MISCW[3]) { unsigned char* wq2_ = p.ws; asm volatile("" : "+v"(wq2_)); xcd_local_barrier((unsigned*)(wq2_ + OFF_CTL), MISCW[5], 32u); } else GSYNC(); } while (0)
#define GSYNC() do { for (int s_ = 0; s_ < PROBE_NSYNC; ++s_) { if (p.ph_hi > 4096) cg::this_grid().sync(); else { XcdBarrier gb_; { unsigned char* wq_ = p.ws; asm volatile("" : "+v"(wq_)); gb_.bar = (unsigned*)(wq_ + OFF_CTL); } gb_.x = xb_xcc_id(); gb_.st = (volatile LAS unsigned*)(lds + LDS_BARST); xcd_barrier(gb_); } } } while (0)

#define LAS __attribute__((address_space(3)))
typedef unsigned short bf16_t;
typedef short bf16x8 __attribute__((ext_vector_type(8)));
typedef float f32x4 __attribute__((ext_vector_type(4)));
typedef float f32x16 __attribute__((ext_vector_type(16)));
typedef unsigned u32x4 __attribute__((ext_vector_type(4)));
typedef unsigned u32x2 __attribute__((ext_vector_type(2)));

constexpr int MT = 32768;
constexpr int SEQ = 8192;
constexpr int DM = 1024;
constexpr int FF = 2816;
constexpr int INW = 1280;
constexpr float EPS = 1e-6f;
constexpr float LOG2E = 1.4426950408889634f;
constexpr float QSCALE_SWA = 0.125f * LOG2E;
constexpr float QSCALE_X = 0.0625f * LOG2E;

constexpr size_t SLOT = 1024 * 1024;
constexpr size_t WO_GU1 = 0;
constexpr size_t WO_D1 = WO_GU1 + (size_t)5632 * 1024 * 2;
constexpr size_t WO_IN = WO_D1 + (size_t)1024 * 2816 * 2;
constexpr size_t WO_OUT = WO_IN + (size_t)1280 * 1024 * 2;
constexpr size_t WO_GU2 = WO_OUT + SLOT * 2;
constexpr size_t WO_D2 = WO_GU2 + (size_t)5632 * 1024 * 2;
constexpr size_t WO_PW = WO_D2 + (size_t)1024 * 2816 * 2;
constexpr size_t WL_BYTES = WO_PW + 4 * 128 * 128 * 2;
constexpr size_t OFF_W = 0;
constexpr size_t OFF_WQN = OFF_W + 2 * WL_BYTES;
constexpr size_t OFF_WOT = OFF_WQN + 2 * SLOT * 2;
constexpr size_t OFF_MEMN = OFF_WOT + 2 * SLOT * 2;
constexpr size_t OFF_WKV = OFF_MEMN + 2 * SLOT * 2;
constexpr size_t OFF_KVH = OFF_WKV + 4 * SLOT * 2;
constexpr size_t OFF_WQK = OFF_KVH + 64 * 65536 * 2;
constexpr size_t OFF_WVO = OFF_WQK + 8 * SLOT * 2;
constexpr size_t OFF_XB = OFF_WVO + 8 * SLOT * 2;
constexpr size_t OFF_ACT = OFF_XB + (size_t)MT * DM * 2;
constexpr size_t OFF_PROJ = OFF_ACT + (size_t)MT * FF * 2;
constexpr size_t OFF_SSQ = OFF_PROJ + (size_t)MT * INW * 2;
constexpr size_t OFF_QF = OFF_SSQ + (size_t)MT * 16 * 4;
constexpr size_t OFF_VTG = OFF_QF + (size_t)MT * 512 * 2;
constexpr size_t OFF_COS = OFF_VTG + (size_t)4 * 128 * SEQ * 2;
constexpr size_t OFF_SIN = OFF_COS + (size_t)MT * 32 * 4;
constexpr size_t OFF_CTL = OFF_SIN + (size_t)MT * 32 * 4;
constexpr size_t DO_P = 0, DO_MRG = (size_t)8 << 20;
__device__ __forceinline__ size_t drow(size_t r) { return ((r >> 12) << 23) + (r & 4095) * 1024; }
constexpr size_t CTL_BYTES = 32768;
constexpr size_t WS_END = OFF_CTL + CTL_BYTES;

constexpr int LDS_XCH = 131072;
constexpr int LDS_BARST = 131072 + 8192 + 512;
constexpr int LDS_RS = 131072 + 8192 + 1024;
constexpr int LDS_BYTES = LDS_RS + 12 * 1024;

__device__ __forceinline__ unsigned cvt_pk_bf16(float lo, float hi) { unsigned r; asm volatile("v_cvt_pk_bf16_f32 %0, %1, %2" : "=v"(r) : "v"(lo), "v"(hi)); return r; }
__device__ __forceinline__ u32x4 pair16(u32x2 we, u32x2 wo) {
    const auto a = __builtin_amdgcn_permlane32_swap(we.x, wo.x, false, false), b = __builtin_amdgcn_permlane32_swap(we.y, wo.y, false, false);
    u32x4 r; r.x = a[0]; r.y = b[0]; r.z = a[1]; r.w = b[1]; return r;
}
__device__ __forceinline__ float bf_lo(unsigned u) { return __uint_as_float(u << 16); }
__device__ __forceinline__ float bf_hi(unsigned u) { return __uint_as_float(u & 0xffff0000u); }
__device__ __forceinline__ float wave_sum(float v) {
#pragma unroll
    for (int o = 1; o < 64; o <<= 1) v += __shfl_xor(v, o);
    return v;
}
__device__ __forceinline__ float rs_of(f32x4 a) { return rsqrtf(((a.x + a.y) + (a.z + a.w)) * (1.0f / 1024.0f) + EPS); }
__device__ __forceinline__ float row_rs(const float* ssq, int row) {
    return rs_of(*(const f32x4*)(ssq + (size_t)row * 4));
}

constexpr int BM = 256, BK = 64, HALF = 128, HTB = HALF * BK * 2, NXCD = 8, WGM = 4;
__device__ __forceinline__ int lds_byte(int r, int c) { const int st = (r >> 4) * 2 + (c >> 5), rr = r & 15, cc = c & 31, ob = rr * 64 + cc * 2; return st * 1024 + (ob ^ (((ob >> 9) & 1) << 5)); }
__device__ __forceinline__ void stage_rc(int b, int& R, int& C) { const int st = b / 1024, sb = b % 1024, swz = sb ^ (((sb >> 9) & 1) << 5); R = (st >> 1) * 16 + swz / 64; C = (st & 1) * 32 + (swz % 64) / 2; }
__device__ __forceinline__ int perm32(int rho) { const int n = rho >> 4, i = rho & 15; return 8 * (i >> 2) + 4 * n + (i & 3); }

struct Unit { int pm, pn; };
struct Gemm { const bf16_t* A; const bf16_t* Bt; int lda, ldb, K, nM, nN, pm_div; size_t a_pm, a_b, a_pn, b_pn, b_b; int c_shift; int a_div; int rev; };
struct StaticOrder {
    int nM, nN, nwg, G, c, nr;
    __device__ void init(int nM_, int nN_, int G_, int c_, int rev_) { nM = nM_; nN = nN_; nwg = nM * nN; G = G_; c = c_; nr = rev_ ? (nwg - 1 - c_) / G_ : -1; }
    __device__ bool next(int i, Unit& u) const {
        if (nr >= 0) { if (c >= nwg || i > nr) return false; i = nr - i; }
        const long L = (long)i * G + c; if (L >= nwg) return false;
        int wgid = (int)L; { const int q = nwg / NXCD, r = nwg % NXCD, xcd = wgid % NXCD, off = wgid / NXCD; wgid = (xcd < r ? xcd * (q + 1) : r * (q + 1) + (xcd - r) * q) + off; }
        const int nig = WGM * nN, gid = wgid / nig, fm = gid * WGM, gsz = (nM - fm) < WGM ? (nM - fm) : WGM;
        u.pm = fm + ((wgid % nig) % gsz); u.pn = (wgid % nig) / gsz; return true;
    }
};

typedef f32x4 Acc[2][2][4][2];

struct EpiGateUp {
    static constexpr bool PERM = true, XCH = false, RS = true;
    const float* ssq; bf16_t* act;
    __device__ __forceinline__ void operator()(Acc& acc, const Unit& u, int ui, int wr, int wc, int fr, int fq, LAS unsigned char* lds) const {
        const LAS float* rsT = (const LAS float*)(lds + LDS_RS) + ui * 256 + wr * 64 + fr;
        const int row0 = u.pm * BM + wr * 64 + fr, col0 = u.pn * 128 + wc * 32 + 8 * fq;
#pragma unroll
        for (int ai = 0; ai < 2; ++ai)
#pragma unroll
            for (int m = 0; m < 4; ++m) {
                const int row = row0 + ai * HALF + m * 16; const float r = rsT[ai * HALF + m * 16];
                const float c1 = -r * LOG2E, r2 = r * r;
                float o[8];
#pragma unroll
                for (int n = 0; n < 2; ++n) { const f32x4 g = acc[ai][0][m][n], up = acc[ai][1][m][n]; const f32x4 t = g * c1;
                    f32x4 e; e.x = __builtin_amdgcn_exp2f(t.x); e.y = __builtin_amdgcn_exp2f(t.y); e.z = __builtin_amdgcn_exp2f(t.z); e.w = __builtin_amdgcn_exp2f(t.w);
                    const f32x4 d = e + 1.0f; f32x4 rc; rc.x = __builtin_amdgcn_rcpf(d.x); rc.y = __builtin_amdgcn_rcpf(d.y); rc.z = __builtin_amdgcn_rcpf(d.z); rc.w = __builtin_amdgcn_rcpf(d.w);
                    const f32x4 v = (g * up) * (rc * r2);
                    o[n * 4 + 0] = v.x; o[n * 4 + 1] = v.y; o[n * 4 + 2] = v.z; o[n * 4 + 3] = v.w; }
                u32x4 w; w.x = cvt_pk_bf16(o[0], o[1]); w.y = cvt_pk_bf16(o[2], o[3]); w.z = cvt_pk_bf16(o[4], o[5]); w.w = cvt_pk_bf16(o[6], o[7]);
                *(u32x4*)(act + (size_t)row * FF + col0) = w;
            }
    }
};
struct EpiResid {
    static constexpr bool PERM = true, XCH = false, RS = false;
    bf16_t* xb; float* ssq; float alpha;
    __device__ __forceinline__ void operator()(Acc& acc, const Unit& u, int ui, int wr, int wc, int fr, int fq, LAS unsigned char* lds) const {
        LAS float* X = (LAS float*)(lds + LDS_XCH);
        const int row0 = u.pm * BM + wr * 64 + fr, col0 = u.pn * BM + wc * 32 + 8 * fq;
#pragma unroll
        for (int ai = 0; ai < 2; ++ai)
#pragma unroll
            for (int m = 0; m < 4; ++m) {
                const int row = row0 + ai * HALF + m * 16; bf16_t* xr = xb + (size_t)row * DM + col0; float q = 0.f;
                const u32x4 x0 = *(const u32x4*)xr, x1 = *(const u32x4*)(xr + HALF);
#pragma unroll
                for (int bj = 0; bj < 2; ++bj) { const u32x4 xo = bj ? x1 : x0; float v[8];
#pragma unroll
                    for (int n = 0; n < 2; ++n) { const f32x4 a = acc[ai][bj][m][n] * alpha;
                        v[4 * n + 0] = bf_lo(xo[2 * n]) + a.x; v[4 * n + 1] = bf_hi(xo[2 * n]) + a.y; v[4 * n + 2] = bf_lo(xo[2 * n + 1]) + a.z; v[4 * n + 3] = bf_hi(xo[2 * n + 1]) + a.w; }
#pragma unroll
                    for (int j = 0; j < 8; ++j) q += v[j] * v[j];
                    u32x4 w; w.x = cvt_pk_bf16(v[0], v[1]); w.y = cvt_pk_bf16(v[2], v[3]); w.z = cvt_pk_bf16(v[4], v[5]); w.w = cvt_pk_bf16(v[6], v[7]);
                    *(u32x4*)(xr + bj * HALF) = w; }
                q += __shfl_xor(q, 16); q += __shfl_xor(q, 32);
                if (fq == 0) X[(ai * HALF + wr * 64 + m * 16 + fr) * 4 + wc] = q;
            }
        asm volatile("s_waitcnt lgkmcnt(0)" ::: "memory"); __builtin_amdgcn_s_barrier(); asm volatile("" ::: "memory");
        const int t = (wr * 4 + wc) * 64 + fq * 16 + fr;
        if (t < 256) { const f32x4 v = *(const LAS f32x4*)(X + t * 4); ssq[(size_t)(u.pm * BM + t) * 4 + u.pn] = (v.x + v.y) + (v.z + v.w); }
        asm volatile("s_waitcnt lgkmcnt(0)" ::: "memory");
    }
};
struct EpiWin {
    static constexpr bool PERM = true, XCH = false, RS = true;
    const float* ssq; const float* cs; const float* sn; bf16_t* proj; bf16_t* qf; bf16_t* vtg;
    __device__ __forceinline__ void operator()(Acc& acc, const Unit& u, int ui, int wr, int wc, int fr, int fq, LAS unsigned char* lds) const {
        const LAS float* rsT = (const LAS float*)(lds + LDS_RS) + ui * 256 + wr * 64 + fr;
        const int row0 = u.pm * BM + wr * 64 + fr, tile = u.pn;
        const bool rope = (tile < 2) || (tile == 2 && wc < 2);
#pragma unroll
        for (int ai = 0; ai < 2; ++ai)
#pragma unroll
            for (int m = 0; m < 4; ++m) {
                const int row = row0 + ai * HALF + m * 16; float r = rsT[ai * HALF + m * 16];
                bf16_t* prow = proj + (size_t)row * INW;
                float o0[8], o1[8]; int c0, c1;
                if (rope) {
                    if (tile < 2) r *= QSCALE_SWA;
                    const f32x4 ca = *(const f32x4*)(cs + (size_t)row * 32 + 8 * fq), cb = *(const f32x4*)(cs + (size_t)row * 32 + 8 * fq + 4);
                    const f32x4 sa = *(const f32x4*)(sn + (size_t)row * 32 + 8 * fq), sb = *(const f32x4*)(sn + (size_t)row * 32 + 8 * fq + 4);
#pragma unroll
                    for (int n = 0; n < 2; ++n)
#pragma unroll
                        for (int j = 0; j < 4; ++j) { const float x1 = acc[ai][0][m][n][j] * r, x2 = acc[ai][1][m][n][j] * r; const float c = n ? cb[j] : ca[j], s = n ? sb[j] : sa[j];
                            o0[n * 4 + j] = x1 * c - x2 * s; o1[n * 4 + j] = x2 * c + x1 * s; }
                    c0 = (tile < 2 ? tile * 256 : 512) + wc * 64 + 8 * fq; c1 = c0 + 32;
                } else {
#pragma unroll
                    for (int n = 0; n < 2; ++n)
#pragma unroll
                        for (int j = 0; j < 4; ++j) { o0[n * 4 + j] = acc[ai][0][m][n][j] * r; o1[n * 4 + j] = acc[ai][1][m][n][j] * r; }
                    if (tile == 2) { c0 = 640 + 32 * (wc - 2) + 8 * fq; c1 = c0 + 64; }
                    else { c0 = tile * 256 + wc * 32 + 8 * fq; c1 = c0 + 128; }
                }
                u32x4 w0, w1; w0.x = cvt_pk_bf16(o0[0], o0[1]); w0.y = cvt_pk_bf16(o0[2], o0[3]); w0.z = cvt_pk_bf16(o0[4], o0[5]); w0.w = cvt_pk_bf16(o0[6], o0[7]);
                w1.x = cvt_pk_bf16(o1[0], o1[1]); w1.y = cvt_pk_bf16(o1[2], o1[3]); w1.z = cvt_pk_bf16(o1[4], o1[5]); w1.w = cvt_pk_bf16(o1[6], o1[7]);
                if (tile < 2) {
                    bf16_t* qb = qf + ((((size_t)(row >> 5) * 8 + tile * 4 + wc) * 4 + (fq >> 1)) * 2 + (fq & 1)) * 256 + (size_t)(row & 31) * 8;
                    *(u32x4*)qb = w0; *(u32x4*)(qb + 2 * 2 * 256) = w1;
                } else if (tile == 2 && wc >= 2) {
                    bf16_t* vb = vtg + ((size_t)(row >> 13) * 128 + 32 * (wc - 2) + 8 * fq) * SEQ + (row & (SEQ - 1));
#pragma unroll
                    for (int e = 0; e < 4; ++e) { vb[(size_t)(2 * e) * SEQ] = (bf16_t)(w0[e] & 0xffffu); vb[(size_t)(2 * e + 1) * SEQ] = (bf16_t)(w0[e] >> 16);
                        vb[(size_t)(64 + 2 * e) * SEQ] = (bf16_t)(w1[e] & 0xffffu); vb[(size_t)(64 + 2 * e + 1) * SEQ] = (bf16_t)(w1[e] >> 16); }
                } else { *(u32x4*)(prow + c0) = w0; *(u32x4*)(prow + c1) = w1; }
            }
    }
};
struct EpiBf16 {
    static constexpr bool PERM = true, XCH = false, RS = false;
    bf16_t* out; size_t tb_pm, tb_pn; int ldc, mode; float scale;
    __device__ __forceinline__ void operator()(Acc& acc, const Unit& u, int ui, int wr, int wc, int fr, int fq, LAS unsigned char*) const {
        size_t tb = (size_t)u.pm * tb_pm + (size_t)u.pn * tb_pn;
        if (mode) tb = (size_t)((u.pn >> 2) * 32 + ((u.pm >> 2) * 4 + (u.pn & 3)) * 4 + (u.pm & 3)) * 65536;
        bf16_t* o = out + tb + (size_t)(wr * 64 + fr) * ldc + wc * 32 + 8 * fq;
#pragma unroll
        for (int ai = 0; ai < 2; ++ai)
#pragma unroll
            for (int m = 0; m < 4; ++m) {
#pragma unroll
                for (int bj = 0; bj < 2; ++bj) { const f32x4 v0 = acc[ai][bj][m][0] * scale, v1 = acc[ai][bj][m][1] * scale;
                    u32x4 w; w.x = cvt_pk_bf16(v0.x, v0.y); w.y = cvt_pk_bf16(v0.z, v0.w); w.z = cvt_pk_bf16(v1.x, v1.y); w.w = cvt_pk_bf16(v1.z, v1.w);
                    *(u32x4*)(o + (size_t)(ai * HALF + m * 16) * ldc + bj * HALF) = w; }
            }
    }
};
struct EpiSoftmax {
    static constexpr bool PERM = true, XCH = true, RS = true;
    const float* ssq; bf16_t* out; int ldc;
    __device__ __forceinline__ void operator()(Acc& acc, const Unit& u, int ui, int wr, int wc, int fr, int fq, LAS unsigned char* lds) const {
        const LAS float* rsT = (const LAS float*)(lds + LDS_RS) + ui * 256 + wr * 64 + fr;
        typedef float f32x2v __attribute__((ext_vector_type(2)));
        LAS f32x2v* X = (LAS f32x2v*)(lds + LDS_XCH);
        float mw[2][4];
#pragma unroll
        for (int ai = 0; ai < 2; ++ai)
#pragma unroll
            for (int m = 0; m < 4; ++m) {
                float mx = -3.0e38f; const float r = rsT[ai * HALF + m * 16];
#pragma unroll
                for (int bj = 0; bj < 2; ++bj)
#pragma unroll
                    for (int n = 0; n < 2; ++n) { const f32x4 v = acc[ai][bj][m][n] * r; acc[ai][bj][m][n] = v; mx = fmaxf(mx, fmaxf(fmaxf(v.x, v.y), fmaxf(v.z, v.w))); }
                mx = fmaxf(mx, __shfl_xor(mx, 16)); mx = fmaxf(mx, __shfl_xor(mx, 32));
                float s = 0.f;
#pragma unroll
                for (int bj = 0; bj < 2; ++bj)
#pragma unroll
                    for (int n = 0; n < 2; ++n) { f32x4 v = acc[ai][bj][m][n];
                        v.x = __builtin_amdgcn_exp2f(v.x - mx); v.y = __builtin_amdgcn_exp2f(v.y - mx); v.z = __builtin_amdgcn_exp2f(v.z - mx); v.w = __builtin_amdgcn_exp2f(v.w - mx);
                        s += (v.x + v.y) + (v.z + v.w); acc[ai][bj][m][n] = v; }
                s += __shfl_xor(s, 16); s += __shfl_xor(s, 32);
                mw[ai][m] = mx;
                if (fq == 0) X[(ai * HALF + wr * 64 + m * 16 + fr) * 4 + wc] = (f32x2v){mx, s};
            }
        asm volatile("s_waitcnt lgkmcnt(0)" ::: "memory"); __builtin_amdgcn_s_barrier(); asm volatile("" ::: "memory");
        const int row0 = u.pm * BM + wr * 64 + fr, col0 = u.pn * BM + wc * 32 + 8 * fq;
#pragma unroll
        for (int ai = 0; ai < 2; ++ai)
#pragma unroll
            for (int m = 0; m < 4; ++m) {
                const int rl = ai * HALF + wr * 64 + m * 16 + fr;
                const f32x2v a = X[rl * 4 + 0], b = X[rl * 4 + 1], c = X[rl * 4 + 2], d = X[rl * 4 + 3];
                const float M = fmaxf(fmaxf(a.x, b.x), fmaxf(c.x, d.x));
                const float L = (a.y * __builtin_amdgcn_exp2f(a.x - M) + b.y * __builtin_amdgcn_exp2f(b.x - M)) + (c.y * __builtin_amdgcn_exp2f(c.x - M) + d.y * __builtin_amdgcn_exp2f(d.x - M));
                const float f = __builtin_amdgcn_exp2f(mw[ai][m] - M) / L;
                const int row = row0 + ai * HALF + m * 16;
#pragma unroll
                for (int bj = 0; bj < 2; ++bj) { const f32x4 v0 = acc[ai][bj][m][0] * f, v1 = acc[ai][bj][m][1] * f;
                    u32x4 w; w.x = cvt_pk_bf16(v0.x, v0.y); w.y = cvt_pk_bf16(v0.z, v0.w); w.z = cvt_pk_bf16(v1.x, v1.y); w.w = cvt_pk_bf16(v1.z, v1.w);
                    *(u32x4*)(out + drow((size_t)row) + col0 + bj * HALF) = w; }
            }
        asm volatile("s_waitcnt lgkmcnt(0)" ::: "memory");
    }
};

template <class Epi>
__device__ __forceinline__ void gemm_phase(LAS unsigned char* lds, const Gemm g, const Epi& E) {
    constexpr bool ALIGN_EPI = true;
    int tid_ = threadIdx.x; asm volatile("" : "+v"(tid_));
    const int tid = tid_, wid = __builtin_amdgcn_readfirstlane(tid >> 6), lane = tid & 63, wr = wid >> 2, wc = wid & 3, fr = lane & 15, fq = lane >> 4;
    const int nt = g.K / BK;
    const unsigned vcu = ((volatile LAS unsigned*)(lds + LDS_BARST))[2];
    StaticOrder S; S.init(g.nM, g.nN, (int)gridDim.x, (int)((vcu + gridDim.x - (unsigned)g.c_shift % gridDim.x) % gridDim.x), g.rev);
    unsigned voffA[2], voffB[2];
#pragma unroll
    for (int i = 0; i < 2; ++i) { int R, C; stage_rc(tid * 16 + i * 8192, R, C); const int Rb = Epi::PERM ? ((R & ~31) + perm32(R & 31)) : R;
        voffA[i] = (unsigned)(R * g.lda + C) * 2u; voffB[i] = (unsigned)(Rb * g.ldb + C) * 2u; }
    const size_t kstep = (size_t)(BK * 2);
    const size_t hstepA = (size_t)HALF * g.lda * 2, hstepB = (size_t)HALF * g.ldb * 2;
    const unsigned ldsw = (unsigned)wid * 1024u;
    const int aoff = lds_byte(wr * 64 + fr, fq * 8), boff = lds_byte(wc * 32 + fr, fq * 8);
#define G_ABASE(u) ((const char*)(g.A + (size_t)((u).pm % (g.a_div ? g.a_div : g.pm_div)) * g.a_pm + (size_t)((u).pm / (g.a_div ? g.a_div : g.pm_div)) * g.a_b + (size_t)(u).pn * g.a_pn))
#define G_BBASE(u) ((const char*)(g.Bt + (size_t)(u).pn * g.b_pn + (size_t)((u).pm / g.pm_div) * g.b_b))
#define PG8_SA(b, h) (((b) * 2 + (h)) * HTB)
#define PG8_SB(b, h) ((4 + (b) * 2 + (h)) * HTB)
#define PG8_STAGE(bufoff, gbase, voff) do { _Pragma("unroll") for (int _i = 0; _i < 2; ++_i) \
        __builtin_amdgcn_global_load_lds((const unsigned*)((const char*)(gbase) + (voff)[_i]), (LAS unsigned*)(lds + (bufoff) + ldsw + _i * 8192), 16, 0, 0); } while (0)
#define PG8_LDA(dst, b, h) do { _Pragma("unroll") for (int m = 0; m < 4; ++m) _Pragma("unroll") for (int k = 0; k < 2; ++k) dst[m][k] = *(const LAS bf16x8*)(lds + PG8_SA(b, h) + aoff + m * 2048 + k * 1024); } while (0)
#define PG8_LDB(dst, b, h) do { _Pragma("unroll") for (int n = 0; n < 2; ++n) _Pragma("unroll") for (int k = 0; k < 2; ++k) dst[n][k] = *(const LAS bf16x8*)(lds + PG8_SB(b, h) + boff + n * 2048 + k * 1024); } while (0)
#define PG8_MMA(ai, bj, At, Bt) do { __builtin_amdgcn_s_setprio(1); _Pragma("unroll") for (int m = 0; m < 4; ++m) _Pragma("unroll") for (int n = 0; n < 2; ++n) _Pragma("unroll") for (int k = 0; k < 2; ++k) \
        acc[ai][bj][m][n] = __builtin_amdgcn_mfma_f32_16x16x32_bf16(Bt[n][k], At[m][k], acc[ai][bj][m][n], 0, 0, 0); __builtin_amdgcn_s_setprio(0); } while (0)
#define PG8_WAIT_V(n) asm volatile("s_waitcnt vmcnt(" #n ")" ::: "memory")
#define PG8_WAIT_L(n) asm volatile("s_waitcnt lgkmcnt(" #n ")" ::: "memory")
#define PG8_BAR __builtin_amdgcn_s_barrier()
#define PG8_SCHED __builtin_amdgcn_sched_barrier(0)
    Unit cur, nxt; int ui = 0;
    if (!S.next(0, cur)) return;
    Acc acc;
#pragma unroll
    for (int a = 0; a < 2; ++a)
#pragma unroll
        for (int b = 0; b < 2; ++b)
#pragma unroll
            for (int m = 0; m < 4; ++m)
#pragma unroll
                for (int n = 0; n < 2; ++n) acc[a][b][m][n] = (f32x4){0.f, 0.f, 0.f, 0.f};
    bf16x8 At[4][2], B0[2][2], B1[2][2];
    const char* cA = G_ABASE(cur); const char* cB = G_BBASE(cur);
    PG8_STAGE(PG8_SB(0, 0), cB, voffB); PG8_STAGE(PG8_SB(0, 1), cB + hstepB, voffB); PG8_STAGE(PG8_SA(0, 0), cA, voffA); PG8_STAGE(PG8_SA(0, 1), cA + hstepA, voffA);
    if constexpr (Epi::RS) {
        f32x4 pv[6]; bool ok[6];
#pragma unroll
        for (int j = 0; j < 6; ++j) { Unit tu; ok[j] = S.next((tid >> 8) + 2 * j, tu); pv[j] = (f32x4){0.f, 0.f, 0.f, 0.f}; if (ok[j]) pv[j] = *(const f32x4*)(E.ssq + (size_t)(tu.pm * BM + (tid & 255)) * 4); }
#pragma unroll
        for (int j = 0; j < 6; ++j) if (ok[j]) ((LAS float*)(lds + LDS_RS))[((tid >> 8) + 2 * j) * 256 + (tid & 255)] = rs_of(pv[j]);
        asm volatile("s_waitcnt lgkmcnt(0)" ::: "memory"); __builtin_amdgcn_s_barrier(); asm volatile("" ::: "memory");
    }
    if (wr == 1) PG8_BAR;
    PG8_WAIT_V(2); PG8_BAR;
    PG8_STAGE(PG8_SB(1, 0), cB + kstep, voffB); PG8_STAGE(PG8_SA(1, 0), cA + kstep, voffA); PG8_STAGE(PG8_SB(1, 1), cB + hstepB + kstep, voffB);
    PG8_WAIT_V(6); PG8_BAR;
    for (;;) {
        const bool has_next = S.next(ui + 1, nxt);
        const char* nA = has_next ? G_ABASE(nxt) : cA; const char* nB = has_next ? G_BBASE(nxt) : cB;
        for (int t = 0; t < nt; t += 2) {
            const bool last = (t == nt - 2);
            const char* a1 = cA + (size_t)(t + 1) * kstep;
            const char* a2 = last ? nA : cA + (size_t)(t + 2) * kstep; const char* b2 = last ? nB : cB + (size_t)(t + 2) * kstep;
            const char* a3 = a2 + kstep; const char* b3 = b2 + kstep;
            PG8_LDB(B0, 0, 0); PG8_LDB(B1, 0, 1); PG8_SCHED; PG8_LDA(At, 0, 0); PG8_STAGE(PG8_SA(1, 1), a1 + hstepA, voffA);
            PG8_WAIT_V(8); PG8_WAIT_L(0); PG8_BAR; PG8_MMA(0, 0, At, B0); PG8_MMA(0, 1, At, B1); PG8_BAR; PG8_SCHED;
            PG8_LDA(At, 0, 1); PG8_STAGE(PG8_SB(0, 0), b2, voffB); PG8_STAGE(PG8_SB(0, 1), b2 + hstepB, voffB); PG8_STAGE(PG8_SA(0, 0), a2, voffA);
            PG8_WAIT_V(8); PG8_WAIT_L(0); PG8_BAR; PG8_MMA(1, 0, At, B0); PG8_MMA(1, 1, At, B1); PG8_BAR; PG8_SCHED;
            PG8_LDB(B0, 1, 0); PG8_LDB(B1, 1, 1); PG8_SCHED; PG8_LDA(At, 1, 0); PG8_STAGE(PG8_SA(0, 1), a2 + hstepA, voffA);
            PG8_WAIT_V(8); PG8_WAIT_L(0); PG8_BAR; PG8_MMA(0, 0, At, B0); PG8_MMA(0, 1, At, B1); PG8_BAR; PG8_SCHED;
            PG8_LDA(At, 1, 1); PG8_STAGE(PG8_SB(1, 0), b3, voffB); PG8_STAGE(PG8_SB(1, 1), b3 + hstepB, voffB); PG8_STAGE(PG8_SA(1, 0), a3, voffA);
            PG8_WAIT_V(8); PG8_WAIT_L(0); PG8_BAR; PG8_MMA(1, 0, At, B0); PG8_MMA(1, 1, At, B1); PG8_BAR; PG8_SCHED;
        }
        if constexpr (ALIGN_EPI) { if (wr == 0) PG8_BAR; }
        E(acc, cur, ui, wr, wc, fr, fq, lds);
        if (!has_next) break;
#pragma unroll
        for (int a = 0; a < 2; ++a)
#pragma unroll
            for (int b = 0; b < 2; ++b)
#pragma unroll
                for (int m = 0; m < 4; ++m)
#pragma unroll
                    for (int n = 0; n < 2; ++n) acc[a][b][m][n] = (f32x4){0.f, 0.f, 0.f, 0.f};
        cur = nxt; cA = nA; cB = nB; ++ui;
        if constexpr (ALIGN_EPI) { if (wr == 1) PG8_BAR; }
    }
    PG8_WAIT_V(0);
    if constexpr (!ALIGN_EPI) { if (wr == 0) PG8_BAR; }
    PG8_BAR;
#undef G_ABASE
#undef G_BBASE
#undef PG8_SA
#undef PG8_SB
#undef PG8_STAGE
#undef PG8_LDA
#undef PG8_LDB
#undef PG8_MMA
#undef PG8_WAIT_V
#undef PG8_WAIT_L
#undef PG8_BAR
#undef PG8_SCHED
}

enum { MAP_ID = 0, MAP_GATE = 1, MAP_UP = 2, MAP_WIN = 3 };
__device__ __forceinline__ int map_row(int kind, int n) {
    if (kind == MAP_GATE) return 256 * (n >> 7) + (n & 127);
    if (kind == MAP_UP) return 256 * (n >> 7) + 128 + (n & 127);
    if (kind == MAP_WIN) {
        if (n < 512) { const int head = n >> 6, d = n & 63, tile = head >> 2, hh = head & 3; return 256 * tile + (d < 32 ? 32 * hh + d : 128 + 32 * hh + d - 32); }
        if (n < 640) { const int kh = (n - 512) >> 6, d = n & 63; return 512 + (d < 32 ? 32 * kh + d : 128 + 32 * kh + d - 32); }
        if (n < 768) { const int vc = n - 640; return 512 + (vc < 64 ? 64 + vc : 128 + 64 + (vc - 64)); }
        return n;
    }
    return n;
}
__device__ __forceinline__ void conv_item(const float* W, const float* gain, int K, int N, bf16_t* WT, int kind, bool hm, LAS float* scr, int item, int lane) {
    const int nblk = N / 32, kb = item / nblk, nb = item % nblk, k0 = 64 * kb, n0 = 32 * nb;
    {
        const int kr = lane >> 3, c4 = lane & 7; f32x4 v[8]; float gv[8];
#pragma unroll
        for (int i = 0; i < 8; ++i) { v[i] = __builtin_nontemporal_load((const f32x4*)(W + (size_t)(k0 + 8 * i + kr) * N + n0 + 4 * c4));     gv[i] = gain ? gain[k0 + 8 * i + kr] : 1.0f; }
#pragma unroll
        for (int i = 0; i < 8; ++i) { LAS float* d = scr + (8 * i + kr) * 33 + 4 * c4; d[0] = v[i].x * gv[i]; d[1] = v[i].y * gv[i]; d[2] = v[i].z * gv[i]; d[3] = v[i].w * gv[i]; }
    }
    asm volatile("s_waitcnt lgkmcnt(0)" ::: "memory");
    const int c = lane & 7;
#pragma unroll
    for (int j = 0; j < 4; ++j) { const int n = (lane >> 3) + 8 * j; const LAS float* s = scr + (8 * c) * 33 + n;
        u32x4 o; o.x = cvt_pk_bf16(s[0 * 33], s[1 * 33]); o.y = cvt_pk_bf16(s[2 * 33], s[3 * 33]); o.z = cvt_pk_bf16(s[4 * 33], s[5 * 33]); o.w = cvt_pk_bf16(s[6 * 33], s[7 * 33]);
        const int kc = k0 + 8 * c; bf16_t* dp = hm ? WT + ((size_t)(kc >> 8) * N + n0 + n) * 256 + (kc & 255) : WT + (size_t)map_row(kind, n0 + n) * K + kc;
        *(u32x4*)dp = o; }
    asm volatile("s_waitcnt lgkmcnt(0)" ::: "memory");
}

struct Params { const float* in[25]; float* out; unsigned char* ws; int ph_lo, ph_hi; };

__device__ __forceinline__ void prologue(const Params& p, LAS unsigned char* lds) {
    int tid_ = threadIdx.x; asm volatile("" : "+v"(tid_));
    const int tid = tid_, lane = tid & 63, wave = __builtin_amdgcn_readfirstlane(tid >> 6);
    LAS float* scr = (LAS float*)(lds + wave * 16384);
    const int gw = blockIdx.x * 8 + wave, NGW = gridDim.x * 8;
    unsigned char* ws = p.ws;
    constexpr int IPL = 1408 * 6 + 640 + 512 * 2 + 1024 + 32;
    for (int it = gw; it < 2 * IPL; it += NGW) {
        const int l = it / IPL; int r = it % IPL; size_t wl_extra = 0;
        unsigned char* wl = ws + OFF_W + (size_t)l * WL_BYTES;
        int wi, gi = -1, K = 1024, N = 1024, kind = MAP_ID; size_t wstride = SLOT, doff; bool in_wl = true, hm = false;
        if (r < 1408) { wi = 4; gi = 3; N = FF; kind = MAP_GATE; wstride = (size_t)DM * FF; doff = WO_GU1; }
        else if ((r -= 1408) < 1408) { wi = 5; gi = 3; N = FF; kind = MAP_UP; wstride = (size_t)DM * FF; doff = WO_GU1; }
        else if ((r -= 1408) < 1408) { wi = 6; K = FF; wstride = (size_t)DM * FF; doff = WO_D1; }
        else if ((r -= 1408) < 640) { wi = 8; gi = 7; N = INW; kind = MAP_WIN; wstride = (size_t)DM * INW; doff = WO_IN; }
        else if ((r -= 640) < 512) { wi = 14; doff = WO_OUT; }
        else if ((r -= 512) < 1024) { wi = 18; N = 2048; wstride = 2 * SLOT; in_wl = false; doff = OFF_WKV + (size_t)l * 2 * SLOT * 2; }
        else if ((r -= 1024) < 512) { wi = 19; in_wl = false; hm = true; doff = OFF_WOT + (size_t)l * SLOT * 2; }
        else if ((r -= 512) < 1408) { wi = 21; gi = 20; N = FF; kind = MAP_GATE; wstride = (size_t)DM * FF; doff = WO_GU2; }
        else if ((r -= 1408) < 1408) { wi = 22; gi = 20; N = FF; kind = MAP_UP; wstride = (size_t)DM * FF; doff = WO_GU2; }
        else if ((r -= 1408) < 1408) { wi = 23; K = FF; wstride = (size_t)DM * FF; doff = WO_D2; }
        else { r -= 1408; const int g4 = r >> 3; r &= 7; wi = 10; K = 128; N = 128; wstride = 4 * 128 * 128; doff = WO_PW + (size_t)g4 * 128 * 128 * 2; wl_extra = (size_t)g4 * 128 * 128; }
        const float* W = (wi == 4 ? p.in[4] : wi == 5 ? p.in[5] : wi == 6 ? p.in[6] : wi == 8 ? p.in[8] : wi == 14 ? p.in[14] : wi == 18 ? p.in[18] : wi == 19 ? p.in[19] : wi == 21 ? p.in[21] : wi == 22 ? p.in[22] : wi == 23 ? p.in[23] : p.in[10]) + (size_t)l * wstride + wl_extra;
        const float* gain = gi < 0 ? nullptr : (gi == 3 ? p.in[3] : gi == 7 ? p.in[7] : p.in[20]) + l * DM;
        bf16_t* dst = (bf16_t*)((in_wl ? wl : ws) + doff);
        conv_item(W, gain, K, N, dst, kind, hm, scr, r, lane);
    }
    for (int it = gw; it < 2 * 1024; it += NGW) {
        const int l = it >> 10, row = it & 1023;
        const f32x4* xr = (const f32x4*)(p.in[1] + (size_t)row * DM) + lane; const f32x4* gr = (const f32x4*)(p.in[16] + l * DM) + lane;
        f32x4 v[4]; float s = 0.f;
#pragma unroll
        for (int j = 0; j < 4; ++j) { v[j] = xr[64 * j]; s += (v[j].x * v[j].x + v[j].y * v[j].y) + (v[j].z * v[j].z + v[j].w * v[j].w); }
        const float r = rsqrtf(wave_sum(s) * (1.0f / 1024.0f) + EPS);
        bf16_t* oa = (bf16_t*)(ws + OFF_MEMN) + (size_t)l * SLOT + (size_t)row * DM;
#pragma unroll
        for (int j = 0; j < 4; ++j) { const f32x4 g = gr[64 * j]; u32x2 w; w.x = cvt_pk_bf16(v[j].x * r * g.x, v[j].y * r * g.y); w.y = cvt_pk_bf16(v[j].z * r * g.z, v[j].w * r * g.w);
            *((u32x2*)oa + lane + 64 * j) = w; }
    }
    for (int it = gw; it < 2 * 1024; it += NGW) {
        const int l = it >> 10, k = it & 1023;
        const f32x4* xr = (const f32x4*)(p.in[17] + (size_t)l * SLOT + (size_t)k * DM) + lane; const float g = p.in[15][l * DM + k];
        bf16_t* o = (bf16_t*)(ws + OFF_WQN) + (size_t)l * SLOT + (size_t)k * 256;
#pragma unroll
        for (int j = 0; j < 4; ++j) { const f32x4 v = xr[64 * j]; u32x2 w; w.x = cvt_pk_bf16(v.x * g, v.y * g); w.y = cvt_pk_bf16(v.z * g, v.w * g);
            *((u32x2*)(o + (size_t)j * 1024 * 256) + lane) = w; }
    }
    for (int rb = gw * 4; rb < MT; rb += NGW * 4) {
        f32x4 v[4][4];
#pragma unroll
        for (int q = 0; q < 4; ++q) { const f32x4* xr = (const f32x4*)(p.in[0] + (size_t)(rb + q) * DM) + lane;
#pragma unroll
            for (int j = 0; j < 4; ++j) v[q][j] = __builtin_nontemporal_load(xr + 64 * j); }
#pragma unroll
        for (int q = 0; q < 4; ++q) { float s = 0.f;
#pragma unroll
            for (int j = 0; j < 4; ++j) s += (v[q][j].x * v[q][j].x + v[q][j].y * v[q][j].y) + (v[q][j].z * v[q][j].z + v[q][j].w * v[q][j].w);
            s = wave_sum(s);
            bf16_t* o = (bf16_t*)(ws + OFF_XB) + (size_t)(rb + q) * DM;
#pragma unroll
            for (int j = 0; j < 4; ++j) { u32x2 w; w.x = cvt_pk_bf16(v[q][j].x, v[q][j].y); w.y = cvt_pk_bf16(v[q][j].z, v[q][j].w); *((u32x2*)o + lane + 64 * j) = w; }
            if (lane < 4) ((float*)(ws + OFF_SSQ))[(size_t)(rb + q) * 4 + lane] = (lane == 0) ? s : 0.f; }
    }
    {
        const int* pos = (const int*)p.in[2]; float* cs = (float*)(ws + OFF_COS); float* sn = (float*)(ws + OFF_SIN);
        const int gt = blockIdx.x * 512 + tid, NGT = gridDim.x * 512;
        for (int i = gt; i < MT * 32; i += NGT) { const int row = i >> 5, f = i & 31;
            const float inv = powf(10000.0f, -(float)(2 * f) / 64.0f); const float ang = (float)pos[row] * inv;
            cs[i] = cosf(ang); sn[i] = sinf(ang); }
    }
}

constexpr int MX_KS = 0, MX_KSTR = 272, MX_VT = 160 * 272, MX_VSTR = 328, MX_XA = 86016, MX_XB = 87040;
constexpr int MX_US = 88064, MX_PL = 0, MX_PSTR = 1040;
static_assert(MX_VT + 128 * MX_VSTR <= MX_XA && MX_PL + 32 * MX_PSTR <= MX_VT && MX_US + 47 * 1024 <= LDS_BYTES, "mixer LDS map");
__device__ __forceinline__ int crow(int r, int hi) { return (r & 3) + 8 * (r >> 2) + 4 * hi; }

template <int W> __device__ __forceinline__ void pool_w(const LAS unsigned* U, LAS unsigned char* pl, int t0, int ts, int cp) {
    unsigned uu[16 + W - 1];
#pragma unroll
    for (int i = 0; i < 16 + W - 1; ++i) uu[i] = U[(ts + 15 - (W - 1) + i) * 256];
    float s0 = 0.f, s1 = 0.f;
#pragma unroll
    for (int i = 0; i < W - 1; ++i) { s0 += bf_lo(uu[i]); s1 += bf_hi(uu[i]); }
#pragma unroll
    for (int t = 0; t < 16; ++t) {
        const float c0 = bf_lo(uu[W - 1 + t]), c1 = bf_hi(uu[W - 1 + t]); s0 += c0; s1 += c1;
        const int tp = t0 + ts + t + 1; const float inv = (tp < W) ? 1.0f / (float)tp : 1.0f / (float)W;
        *(LAS unsigned*)(pl + (ts + t) * MX_PSTR + cp * 4) = cvt_pk_bf16(s0 * inv - c0, s1 * inv - c1);
        s0 -= bf_lo(uu[t]); s1 -= bf_hi(uu[t]);
    }
}
constexpr int MX_TAB = LDS_RS;
static_assert(MX_TAB + 3 * 2048 <= LDS_BYTES && MX_US + 47 * 1024 <= LDS_BARST && MX_TAB > LDS_BARST + 16, "mixer LDS map (tables)");

#define MX_BAR() do { asm volatile("s_waitcnt lgkmcnt(0)" ::: "memory"); __builtin_amdgcn_s_barrier(); asm volatile("" ::: "memory"); } while (0)
__device__ __forceinline__ void mixer_phase(LAS unsigned char* lds, const bf16_t* proj, const bf16_t* qfg, const bf16_t* vtg, bf16_t* mrg, const bf16_t* pwT, const float* sinks, const float* gA, const float* gB, const float* pscale) {
    int tid_ = threadIdx.x;
    {
        asm volatile("" : "+v"(tid_));
        LAS float* tab = (LAS float*)(lds + MX_TAB);
        tab[tid_] = gA[tid_]; tab[512 + tid_] = gB[tid_]; tab[1024 + tid_] = pscale[tid_];
    }
    const int vcu = (int)((volatile LAS unsigned*)(lds + LDS_BARST))[2];
    for (int unit0 = vcu; unit0 < MT / 32; unit0 += gridDim.x) {
        const int unit = (gridDim.x == 256) ? 128 * (vcu & 7) + (vcu >> 3) + 32 * (unit0 >> 8) : unit0;
        asm volatile("" : "+v"(tid_));
        const int tid = tid_, lane = tid & 63, wid = __builtin_amdgcn_readfirstlane(tid >> 6), r32 = lane & 31, hi = lane >> 5;
        const int b = unit >> 8, t0 = (unit & 255) * 32; const size_t row0 = (size_t)b * SEQ + t0;
#pragma unroll
        for (int i = 0; i < 5; ++i) { const int idx = tid + 512 * i, key = idx >> 4, ch = idx & 15; u32x4 v = (u32x4){0u, 0u, 0u, 0u};
            if (t0 - 128 + key >= 0) v = *(const u32x4*)(proj + (row0 - 128 + key) * INW + 512 + ch * 8);
            *(LAS u32x4*)(lds + MX_KS + key * MX_KSTR + ch * 16) = v; }
#pragma unroll
        for (int i = 0; i < 5; ++i) { const int idx = tid + 512 * i, chn = idx / 20, key0 = (idx % 20) * 8; u32x4 v = (u32x4){0u, 0u, 0u, 0u};
            if (t0 - 128 + key0 >= 0) v = *(const u32x4*)(vtg + ((size_t)b * 128 + chn) * SEQ + (t0 - 128 + key0));
            LAS u32x2* vt = (LAS u32x2*)(lds + MX_VT + chn * MX_VSTR + key0 * 2); vt[0] = (u32x2){v.x, v.y}; vt[1] = (u32x2){v.z, v.w}; }
#pragma unroll
        for (int i = 0; i < 6; ++i) { const int idx = tid + 512 * i; if (idx < 47 * 64) { const int lr = idx >> 6, ch = idx & 63; u32x4 v = (u32x4){0u, 0u, 0u, 0u};
                if (t0 + lr - 15 >= 0) v = *(const u32x4*)(proj + (row0 + lr - 15) * INW + 768 + ch * 8);
                *(LAS u32x4*)(lds + MX_US + lr * 1024 + ch * 16) = v; } }
        bf16x8 qf[4];
#pragma unroll
        for (int ks = 0; ks < 4; ++ks) qf[ks] = *(const bf16x8*)(qfg + ((((size_t)unit * 8 + wid) * 4 + ks) * 2 + hi) * 256 + r32 * 8);
        MX_BAR();
        const int kvh = wid >> 2;
        f32x16 s[5];
#pragma unroll
        for (int kt = 0; kt < 5; ++kt) {
            f32x16 a = (f32x16){0.f, 0.f, 0.f, 0.f, 0.f, 0.f, 0.f, 0.f, 0.f, 0.f, 0.f, 0.f, 0.f, 0.f, 0.f, 0.f};
#pragma unroll
            for (int ks = 0; ks < 4; ++ks) { const bf16x8 kf = *(const LAS bf16x8*)(lds + MX_KS + (32 * kt + r32) * MX_KSTR + (kvh * 64 + ks * 16 + hi * 8) * 2);
                a = __builtin_amdgcn_mfma_f32_32x32x16_bf16(kf, qf[ks], a, 0, 0, 0); }
            s[kt] = a;
        }
        const float sink2 = sinks[wid] * LOG2E;
        float mx = sink2;
        if (t0 >= 128) {
#pragma unroll
            for (int r = 0; r < 16; ++r) { const int k0 = crow(r, hi); if (k0 <= r32) s[0][r] = -1.0e30f; if (k0 > r32) s[4][r] = -1.0e30f; }
        } else {
#pragma unroll
            for (int kt = 0; kt < 5; ++kt)
#pragma unroll
                for (int r = 0; r < 16; ++r) { const int kk = 32 * kt + crow(r, hi); const int diff = (128 + r32) - kk;
                    const bool ok = (diff >= 0) && (diff < 128) && (t0 - 128 + kk >= 0); if (!ok) s[kt][r] = -1.0e30f; }
        }
#pragma unroll
        for (int kt = 0; kt < 5; ++kt)
#pragma unroll
            for (int r = 0; r < 16; ++r) mx = fmaxf(mx, s[kt][r]);
        mx = fmaxf(mx, __shfl_xor(mx, 32));
        float lsum = 0.f;
#pragma unroll
        for (int kt = 0; kt < 5; ++kt)
#pragma unroll
            for (int r = 0; r < 16; ++r) { const float e = __builtin_amdgcn_exp2f(s[kt][r] - mx); s[kt][r] = e; lsum += e; }
        lsum += __shfl_xor(lsum, 32); lsum += __builtin_amdgcn_exp2f(sink2 - mx);
        const float linv = 1.0f / lsum;
        f32x16 o[2];
#pragma unroll
        for (int dh = 0; dh < 2; ++dh) {
            f32x16 a = (f32x16){0.f, 0.f, 0.f, 0.f, 0.f, 0.f, 0.f, 0.f, 0.f, 0.f, 0.f, 0.f, 0.f, 0.f, 0.f, 0.f};
            const LAS unsigned char* vrow = lds + MX_VT + (kvh * 64 + 32 * dh + r32) * MX_VSTR;
#pragma unroll
            for (int kt = 0; kt < 5; ++kt)
#pragma unroll
                for (int st = 0; st < 2; ++st) {
                    const int key0 = 32 * kt + 16 * st + 4 * hi;
                    const u32x2 v0 = *(const LAS u32x2*)(vrow + key0 * 2), v1 = *(const LAS u32x2*)(vrow + (key0 + 8) * 2);
                    u32x4 av; av.x = v0.x; av.y = v0.y; av.z = v1.x; av.w = v1.y;
                    u32x4 pv; pv.x = cvt_pk_bf16(s[kt][8 * st + 0], s[kt][8 * st + 1]); pv.y = cvt_pk_bf16(s[kt][8 * st + 2], s[kt][8 * st + 3]);
                    pv.z = cvt_pk_bf16(s[kt][8 * st + 4], s[kt][8 * st + 5]); pv.w = cvt_pk_bf16(s[kt][8 * st + 6], s[kt][8 * st + 7]);
                    a = __builtin_amdgcn_mfma_f32_32x32x16_bf16(__builtin_bit_cast(bf16x8, av), __builtin_bit_cast(bf16x8, pv), a, 0, 0, 0);
                    if (st) __builtin_amdgcn_sched_barrier(0);
                }
            o[dh] = a;
        }
        float q2 = 0.f;
#pragma unroll
        for (int dh = 0; dh < 2; ++dh)
#pragma unroll
            for (int r = 0; r < 16; ++r) { const float v = o[dh][r] * linv; o[dh][r] = v; q2 += v * v; }
        q2 += __shfl_xor(q2, 32);
        if (hi == 0) ((LAS float*)(lds + MX_XA))[wid * 32 + r32] = q2;
        MX_BAR();
        {
            float tot = 0.f;
#pragma unroll
            for (int w = 0; w < 8; ++w) tot += ((LAS float*)(lds + MX_XA))[w * 32 + r32];
            const float rA = rsqrtf(tot * (1.0f / 512.0f) + EPS);
            bf16_t* orow = mrg + drow(row0 + r32) + wid * 64;
#pragma unroll
            for (int dh = 0; dh < 2; ++dh)
#pragma unroll
                for (int pq = 0; pq < 2; ++pq) { u32x2 w2[2];
#pragma unroll
                    for (int h2 = 0; h2 < 2; ++h2) { const int rq = 2 * pq + h2, d0 = 32 * dh + 8 * rq + 4 * hi; const f32x4 g = *(const LAS f32x4*)(lds + MX_TAB + (wid * 64 + d0) * 4);
                        w2[h2].x = cvt_pk_bf16(o[dh][4 * rq + 0] * rA * g.x, o[dh][4 * rq + 1] * rA * g.y); w2[h2].y = cvt_pk_bf16(o[dh][4 * rq + 2] * rA * g.z, o[dh][4 * rq + 3] * rA * g.w); }
                    *(u32x4*)(orow + 32 * dh + 16 * pq + 8 * hi) = pair16(w2[0], w2[1]); }
        }
        bf16x8 wf[2][8];
#pragma unroll
        for (int e = 0; e < 2; ++e)
#pragma unroll
            for (int ks = 0; ks < 8; ++ks) wf[e][ks] = *(const bf16x8*)(pwT + ((size_t)((wid >> 1) * 128 + 32 * (2 * (wid & 1) + e) + r32)) * 128 + hi * 8 + ks * 16);
        {
            const int cp = tid & 255, ts = 16 * (tid >> 8), gsel = __builtin_amdgcn_readfirstlane(cp >> 6);
            const LAS unsigned* U = (const LAS unsigned*)(lds + MX_US) + cp;
            if (gsel == 0) pool_w<2>(U, lds + MX_PL, t0, ts, cp); else if (gsel == 1) pool_w<4>(U, lds + MX_PL, t0, ts, cp);
            else if (gsel == 2) pool_w<8>(U, lds + MX_PL, t0, ts, cp); else pool_w<16>(U, lds + MX_PL, t0, ts, cp);
        }
        MX_BAR();
        {
            const int g = wid >> 1, nh = wid & 1;
            f32x16 acc2[2];
#pragma unroll
            for (int e = 0; e < 2; ++e) {
                f32x16 a = (f32x16){0.f, 0.f, 0.f, 0.f, 0.f, 0.f, 0.f, 0.f, 0.f, 0.f, 0.f, 0.f, 0.f, 0.f, 0.f, 0.f};
#pragma unroll
                for (int ks = 0; ks < 8; ++ks) { const bf16x8 af = wf[e][ks];
                    const bf16x8 bfr = *(const LAS bf16x8*)(lds + MX_PL + r32 * MX_PSTR + (g * 128 + ks * 16 + hi * 8) * 2);
                    a = __builtin_amdgcn_mfma_f32_32x32x16_bf16(af, bfr, a, 0, 0, 0); }
                acc2[e] = a;
            }
            float q3 = 0.f;
#pragma unroll
            for (int e = 0; e < 2; ++e)
#pragma unroll
                for (int rq = 0; rq < 4; ++rq) { const int ch = g * 128 + 32 * (2 * nh + e) + 8 * rq + 4 * hi; const f32x4 sc = *(const LAS f32x4*)(lds + MX_TAB + (1024 + ch) * 4);
#pragma unroll
                    for (int j = 0; j < 4; ++j) { const float v = acc2[e][4 * rq + j] * sc[j]; acc2[e][4 * rq + j] = v; q3 += v * v; } }
            q3 += __shfl_xor(q3, 32);
            if (hi == 0) ((LAS float*)(lds + MX_XB))[wid * 32 + r32] = q3;
            MX_BAR();
            float tot = 0.f;
#pragma unroll
            for (int w = 0; w < 8; ++w) tot += ((LAS float*)(lds + MX_XB))[w * 32 + r32];
            const float rB = rsqrtf(tot * (1.0f / 512.0f) + EPS);
            bf16_t* orow = mrg + drow(row0 + r32) + 512;
#pragma unroll
            for (int e = 0; e < 2; ++e)
#pragma unroll
                for (int pq = 0; pq < 2; ++pq) { u32x2 w2[2];
#pragma unroll
                    for (int h2 = 0; h2 < 2; ++h2) { const int rq = 2 * pq + h2, ch = g * 128 + 32 * (2 * nh + e) + 8 * rq + 4 * hi; const f32x4 gg = *(const LAS f32x4*)(lds + MX_TAB + (512 + ch) * 4);
                        w2[h2].x = cvt_pk_bf16(acc2[e][4 * rq + 0] * rB * gg.x, acc2[e][4 * rq + 1] * rB * gg.y); w2[h2].y = cvt_pk_bf16(acc2[e][4 * rq + 2] * rB * gg.z, acc2[e][4 * rq + 3] * rB * gg.w); }
                    *(u32x4*)(orow + g * 128 + 32 * (2 * nh + e) + 16 * pq + 8 * hi) = pair16(w2[0], w2[1]); }
        }
    }
}

#define XB_TMO      128
#define XB_XCNT(j)  (256  + 64 * (j))
#define XB_XSUB(j)  (1280 + 64 * (j))
#define XB_XGEN(j)  (2304 + 64 * (j))
#define XB_TOP      3328
#define XB_TOPGEN   3392
#define XCD_BAR_WORDS 3456
#define XB_SPIN_CAP (1u << 18)

__device__ __forceinline__ unsigned xb_ld(unsigned* p)              { return __hip_atomic_load(p, __ATOMIC_RELAXED, __HIP_MEMORY_SCOPE_AGENT); }
__device__ __forceinline__ unsigned xb_add(unsigned* p, unsigned v) { return __hip_atomic_fetch_add(p, v, __ATOMIC_RELAXED, __HIP_MEMORY_SCOPE_AGENT); }
__device__ __forceinline__ unsigned xb_xcc_id() { return (unsigned)__builtin_amdgcn_s_getreg((3 << 11) | 20) & 0xFu; }
#define XB_SPIN(cond, bar) do { unsigned _sp = 0; while (cond) { __builtin_amdgcn_s_sleep(1); \
    if ((++_sp & 255u) == 0u) { if (xb_ld(&(bar)[XB_TMO])) break; if (_sp > XB_SPIN_CAP) { atomicAdd(&(bar)[XB_TMO], 1u); break; } } } } while (0)

struct XcdBarrier {
    unsigned* bar; unsigned x;
    volatile LAS unsigned* st;
};

__device__ __forceinline__ XcdBarrier xcd_barrier_post(unsigned* bar, volatile LAS unsigned* st) {
    XcdBarrier b; b.bar = bar; b.x = xb_xcc_id(); b.st = st;
    if (threadIdx.x == 0) (void)xb_add(&bar[XB_XCNT(b.x)], 1u);
    return b;
}
__device__ __forceinline__ void xcd_barrier_complete(unsigned* bar, unsigned x, unsigned& nloc, unsigned& nx) {
    const unsigned G = gridDim.x * gridDim.y * gridDim.z;
    unsigned sum, cnt, mine, sp = 0u;
    for (;;) {
        sum = 0u; cnt = 0u; mine = 0u;
#pragma unroll
        for (unsigned j = 0; j < 16; ++j) { const unsigned c = xb_ld(&bar[XB_XCNT(j)]); sum += c; cnt += (c > 0u) ? 1u : 0u; mine = (j == x) ? c : mine; }
        if (sum == G) break;
        __builtin_amdgcn_s_sleep(1);
        if ((++sp & 255u) == 0u) { if (xb_ld(&bar[XB_TMO])) break; if (sp > XB_SPIN_CAP) { atomicAdd(&bar[XB_TMO], 1u); break; } }
    }
    nloc = mine > 0u ? mine : 1u; nx = cnt > 0u ? cnt : 1u;
}

__device__ __forceinline__ void xcd_barrier(const XcdBarrier& b) {
    asm volatile("s_waitcnt vmcnt(0)" ::: "memory");
    __syncthreads();
    if (threadIdx.x == 0) {
        unsigned* bar = b.bar;
        __builtin_amdgcn_s_waitcnt(0);
        unsigned nloc = b.st[0], nx = b.st[1];
        if (nloc == 0u) { xcd_barrier_complete(bar, b.x, nloc, nx); b.st[0] = nloc; b.st[1] = nx; }
        const unsigned old = xb_add(&bar[XB_XSUB(b.x)], 1u);
        const unsigned gen = old / nloc;
        if (old + 1u == (gen + 1u) * nloc) {
            __builtin_amdgcn_fence(__ATOMIC_RELEASE, "agent");
            asm volatile("s_waitcnt vmcnt(0)" ::: "memory");
            const unsigned og = xb_add(&bar[XB_TOP], 1u);
            const unsigned tg = og / nx;
            if (og + 1u == (tg + 1u) * nx) xb_add(&bar[XB_TOPGEN], 1u);
            else XB_SPIN(xb_ld(&bar[XB_TOPGEN]) == tg, bar);
            __builtin_amdgcn_fence(__ATOMIC_ACQUIRE, "agent");
            xb_add(&bar[XB_XGEN(b.x)], 1u);
            asm volatile("s_waitcnt vmcnt(0)" ::: "memory");
        } else {
            XB_SPIN(xb_ld(&bar[XB_XGEN(b.x)]) == gen, bar);
            __builtin_amdgcn_fence(__ATOMIC_ACQUIRE, "agent");
            asm volatile("s_waitcnt vmcnt(0)" ::: "memory");
        }
    }
    __syncthreads();
}

#define XL_SUB(j)   (3456 + 64 * (j))
#define XL_GEN(j)   (3456 + 1024 + 64 * (j))
__device__ __forceinline__ void xcd_local_barrier(unsigned* bar, unsigned x, unsigned nloc) {
    asm volatile("s_waitcnt vmcnt(0)" ::: "memory");
    __syncthreads();
    if (threadIdx.x == 0) {
        __builtin_amdgcn_s_waitcnt(0);
        const unsigned old = xb_add(&bar[XL_SUB(x)], 1u);
        const unsigned gen = old / nloc;
        if (old + 1u == (gen + 1u) * nloc) xb_add(&bar[XL_GEN(x)], 1u);
        else XB_SPIN(xb_ld(&bar[XL_GEN(x)]) == gen, bar);
        __builtin_amdgcn_fence(__ATOMIC_ACQUIRE, "agent");
        asm volatile("s_waitcnt vmcnt(0)" ::: "memory");
    }
    __syncthreads();
}

constexpr int N_HEAD = 1, N_SUB = 9, N_PHASES = N_HEAD + 2 * N_SUB + 1;
__global__ void __launch_bounds__(512) hymba_fwd(Params p) {
    extern __shared__ __attribute__((aligned(16))) unsigned char lds_raw[];
    LAS unsigned char* lds = (LAS unsigned char*)lds_raw;
    unsigned char* ws = p.ws;
    bf16_t* XB = (bf16_t*)(ws + OFF_XB); bf16_t* ACT = (bf16_t*)(ws + OFF_ACT); bf16_t* PROJ = (bf16_t*)(ws + OFF_PROJ); bf16_t* MRG = (bf16_t*)((unsigned char*)p.out + DO_MRG); bf16_t* PB = (bf16_t*)((unsigned char*)p.out + DO_P);
    float* SSQ = (float*)(ws + OFF_SSQ);
    const size_t BIG = (size_t)256 * 1024;
    volatile LAS unsigned* MISCW = (volatile LAS unsigned*)(lds + LDS_BARST);
    if (threadIdx.x < 8) MISCW[threadIdx.x] = (threadIdx.x == 2) ? blockIdx.x : 0u;
    __syncthreads();
    if (threadIdx.x == 0) { const unsigned x_ = xb_xcc_id(); MISCW[5] = x_; MISCW[4] = xb_add(&((unsigned*)(ws + OFF_CTL))[XB_XCNT(x_)], 1u); }
    if (p.ph_lo <= 0 && 0 < p.ph_hi) { for (int rep = 0; rep <= PROBE_PRO; ++rep) { if (rep) GSYNC(); prologue(p, lds); __syncthreads(); } }
    bool synced = false;
    if (p.ph_lo == 0 && p.ph_hi > 1) {
        GSYNC(); synced = true;
        if (threadIdx.x == 0) {
            unsigned* bar = (unsigned*)(ws + OFF_CTL); bool ok = (gridDim.x == 256);
            for (unsigned j = 0; j < 16; ++j) { const unsigned c = xb_ld(&bar[XB_XCNT(j)]); ok = ok && (c == (j < 8 ? 32u : 0u)); }
            if (ok && MISCW[4] < 32u && MISCW[5] < 8u) { MISCW[2] = MISCW[4] * 8u + MISCW[5]; MISCW[3] = 1u; }
        }
        __syncthreads();
    }
    const int ph_a = p.ph_lo > N_HEAD ? p.ph_lo : N_HEAD, ph_b = p.ph_hi < N_PHASES - 1 ? p.ph_hi : N_PHASES - 1;
    for (int ph = ph_a; ph < ph_b; ++ph) {
        const int l = (ph - N_HEAD) / N_SUB, sp = (ph - N_HEAD) % N_SUB;
        for (int rep = 0; rep <= ((PROBE_MASK >> sp) & 1); ++rep) {
        if (rep || (ph > p.ph_lo && !(synced && ph == N_HEAD))) SEAM(!rep && !(l == 0 && sp == 0) && sp != 3 && !(sp == 4 && l == 0));
        unsigned char* wl = ws + OFF_W + (size_t)l * WL_BYTES;
        if (sp == 0 || sp == 7) {
            Gemm g{XB, (const bf16_t*)(wl + (sp == 0 ? WO_GU1 : WO_GU2)), 1024, 1024, 1024, 128, 22, 1 << 30, BIG, 0, 0, BIG, 0, 0, 0, ph & 1};
            EpiGateUp E{SSQ, ACT};
            gemm_phase<EpiGateUp>(lds, g, E);
        } else if (sp == 1 || sp == 8 || sp == 4 || sp == 6) {
            Gemm g;
            if (sp == 1 || sp == 8) g = Gemm{ACT, (const bf16_t*)(wl + (sp == 1 ? WO_D1 : WO_D2)), FF, FF, FF, 128, 4, 1 << 30, (size_t)256 * FF, 0, 0, (size_t)256 * FF, 0, 0, 0, ph & 1};
            else if (sp == 4) g = Gemm{MRG, (const bf16_t*)(wl + WO_OUT), 1024, 1024, 1024, 128, 4, 1 << 30, BIG, (size_t)1 << 23, 0, BIG, 0, 0, 16, ph & 1};
            else g = Gemm{PB, (const bf16_t*)(ws + OFF_WVO) + (size_t)l * 4 * SLOT, 1024, 1024, 1024, 128, 4, 32, BIG, (size_t)1 << 23, 0, BIG, SLOT, 0, 16, ph & 1};
            EpiResid E{XB, SSQ, (sp == 1 || sp == 8) ? 0.5f : 1.0f};
            gemm_phase<EpiResid>(lds, g, E);
        } else if (sp == 2) {
            Gemm g{XB, (const bf16_t*)(wl + WO_IN), 1024, 1024, 1024, 128, 5, 1 << 30, BIG, 0, 0, BIG, 0, 0, 0, ph & 1};
            EpiWin E{SSQ, (const float*)(ws + OFF_COS), (const float*)(ws + OFF_SIN), PROJ, (bf16_t*)(ws + OFF_QF), (bf16_t*)(ws + OFF_VTG)};
            gemm_phase<EpiWin>(lds, g, E);
        } else if (sp == 3) {
            mixer_phase(lds, PROJ, (const bf16_t*)(ws + OFF_QF), (const bf16_t*)(ws + OFF_VTG), MRG, (const bf16_t*)(wl + WO_PW), p.in[9] + l * 8, p.in[12] + l * 512, p.in[13] + l * 512, p.in[11] + l * 512);
        } else if (sp == 5) {
            Gemm g{XB, (const bf16_t*)(ws + OFF_WQK) + (size_t)l * 4 * SLOT, 1024, 1024, 1024, 128, 4, 32, BIG, 32 * BIG, 0, BIG, SLOT, 0, 0, ph & 1};
            EpiSoftmax E{SSQ, PB, 1024};
            gemm_phase<EpiSoftmax>(lds, g, E);
        }
        const int nbf = (l == 0 && rep == 0) ? (sp == 2 ? 1 : sp == 3 ? 16 : 0) : 0;
        for (int i = 0; i < nbf; ++i) {
            Gemm g; EpiBf16 E;
            if (sp == 2) {
                g = Gemm{(const bf16_t*)(ws + OFF_MEMN), (const bf16_t*)(ws + OFF_WKV), 1024, 1024, 1024, 8, 8, 4, BIG, 4 * BIG, 0, BIG, 2 * SLOT, 128};
                E = EpiBf16{(bf16_t*)(ws + OFF_KVH), 0, 0, 256, 1, 1.0f};
            } else {
                const int lh = i & 7, l2 = lh >> 2, h = lh & 3;
                if (i < 8) {
                    g = Gemm{(const bf16_t*)(ws + OFF_KVH) + (size_t)(lh * 4) * 65536, (const bf16_t*)(ws + OFF_WQN) + (size_t)lh * 262144, 256, 256, 256, 4, 4, 1 << 30, 65536, 0, 0, 65536, 0, 16 * i};
                    E = EpiBf16{(bf16_t*)(ws + OFF_WQK) + (size_t)l2 * 4 * SLOT + (size_t)h * 256 * 1024, SLOT, 256, 1024, 0, QSCALE_X};
                } else {
                    g = Gemm{(const bf16_t*)(ws + OFF_WOT) + (size_t)lh * 262144, (const bf16_t*)(ws + OFF_KVH) + (size_t)(32 + lh * 4) * 65536, 256, 256, 256, 4, 4, 1 << 30, 65536, 0, 0, 65536, 0, 16 * i};
                    E = EpiBf16{(bf16_t*)(ws + OFF_WVO) + (size_t)l2 * 4 * SLOT + (size_t)h * 256, BIG, SLOT, 1024, 0, 1.0f};
                }
            }
            gemm_phase<EpiBf16>(lds, g, E);
        }
        }
    }
    if (p.ph_lo <= N_PHASES - 1 && N_PHASES - 1 < p.ph_hi) {
        if (N_PHASES - 1 > p.ph_lo) SEAM(true);
        int tid_ = threadIdx.x; asm volatile("" : "+v"(tid_));
        const int vcu = (int)MISCW[2]; const int lane = tid_ & 63, gw = vcu * 8 + (tid_ >> 6), NGW = gridDim.x * 8;
        for (int row0 = gw; row0 < MT; row0 += NGW) {
            const int k_ = row0 / NGW;
            const int row = (gridDim.x == 256) ? 4096 * (vcu & 7) + 128 * (vcu >> 3) + 16 * (tid_ >> 6) + k_ : row0;
            const float r = row_rs(SSQ, row); const u32x2* xr = (const u32x2*)(XB + (size_t)row * DM) + lane; f32x4* orow = (f32x4*)(p.out + (size_t)row * DM) + lane; const f32x4* gr = (const f32x4*)p.in[24] + lane;
#pragma unroll
            for (int j = 0; j < 4; ++j) { const u32x2 v = xr[64 * j]; const f32x4 g = gr[64 * j]; __builtin_nontemporal_store((f32x4){bf_lo(v.x) * r * g.x, bf_hi(v.x) * r * g.y, bf_lo(v.y) * r * g.z, bf_hi(v.y) * r * g.w}, orow + 64 * j); }
        }
    }
}

extern "C" void kernel_launch(void* const* d_in, const int* in_sizes, int n_in, void* d_out, int out_size, void* d_ws, size_t ws_size, hipStream_t stream) {
    static int grid = 0;
    if (grid == 0) {
        if (n_in != 25 || out_size != MT * DM || ws_size < WS_END) { fprintf(stderr, "kernel_launch: unexpected shapes (n_in %d out %d ws %zu need %zu)\n", n_in, out_size, ws_size, (size_t)WS_END); grid = -1; return; }
        int dev = 0, cus = 0, per_cu = 0;
        hipGetDevice(&dev); hipDeviceGetAttribute(&cus, hipDeviceAttributeMultiprocessorCount, dev);
        if (hipFuncSetAttribute((const void*)hymba_fwd, hipFuncAttributeMaxDynamicSharedMemorySize, LDS_BYTES) != hipSuccess) { fprintf(stderr, "kernel_launch: hipFuncSetAttribute failed\n"); grid = -1; return; }
        if (hipOccupancyMaxActiveBlocksPerMultiprocessor(&per_cu, (const void*)hymba_fwd, 512, LDS_BYTES) != hipSuccess || per_cu < 1) { fprintf(stderr, "kernel_launch: occupancy query gave %d\n", per_cu); per_cu = 1; }
        (void)hipGetLastError();
        grid = cus;
    }
    if (grid < 0) return;
    Params p{};
    for (int i = 0; i < 25; ++i) p.in[i] = (const float*)d_in[i];
    p.out = (float*)d_out; p.ws = (unsigned char*)d_ws;
#if MK_ONE_LAUNCH
    p.ph_lo = 0; p.ph_hi = N_PHASES;
    if (hipMemsetAsync((char*)d_ws + OFF_CTL, 0, CTL_BYTES, stream) != hipSuccess) { fprintf(stderr, "kernel_launch: memset of the barrier words failed\n"); return; }
    void* args[] = {&p};
    hipError_t e = hipLaunchCooperativeKernel((const void*)hymba_fwd, dim3(grid), dim3(512), args, LDS_BYTES, stream);
    if (e != hipSuccess) fprintf(stderr, "cooperative launch failed: %s (grid %d)\n", hipGetErrorString(e), grid);
#else
    for (int ph = 0; ph < N_PHASES; ++ph) { p.ph_lo = ph; p.ph_hi = ph + 1; hipLaunchKernelGGL(hymba_fwd, dim3(grid), dim3(512), LDS_BYTES, stream, p); }
#endif
}
```
